# Optimizing an MI355X kernel written in HIP

```python
import jax, jax.numpy as jnp
from jax import lax
import numpy as np

D_MODEL = 1024
BATCH = 4
SEQ = 8192
DEPTH = 1
DEC_BATCH = 1
DEC_SEQ = 16384
PAST_LEN = 128

MIX_WIDTH = D_MODEL
ATT_HEADS = 8
NOPE_DIM = 64
ROPE_DIM = 32
QK_DIM = NOPE_DIM + ROPE_DIM
V_DIM = 64
Q_RANK = 384
KV_RANK = 256
ATT_WIDTH = ATT_HEADS * V_DIM
ROPE_THETA = 10000.0
Q_BLOCK = 128
RWKV_HEADS = 8
RWKV_HEAD_DIM = 64
RWKV_WIDTH = RWKV_HEADS * RWKV_HEAD_DIM
DECAY_LORA = 64
ICLR_LORA = 64
GATE_LORA = 128
D_FF = 2816
NORM_EPS = 1e-6
LN_X_EPS = 64e-5

OFF_CKV = Q_RANK
OFF_KR = OFF_CKV + KV_RANK
OFF_RWKV = OFF_KR + ROPE_DIM
RWKV_COLS = 3 * RWKV_WIDTH + 2 * DECAY_LORA + 2 * ICLR_LORA + GATE_LORA
IN_COLS = OFF_RWKV + RWKV_COLS
RWKV_SPLITS = (RWKV_WIDTH, 2 * RWKV_WIDTH, 3 * RWKV_WIDTH,
               3 * RWKV_WIDTH + DECAY_LORA, 3 * RWKV_WIDTH + 2 * DECAY_LORA,
               3 * RWKV_WIDTH + 2 * DECAY_LORA + ICLR_LORA,
               3 * RWKV_WIDTH + 2 * DECAY_LORA + 2 * ICLR_LORA)

kernel_name = "hymba_mla_rwkv7_macaron_encoder"


def rmsnorm(x, g):
    xf = x.astype(jnp.float32)
    y = xf * lax.rsqrt(jnp.mean(xf * xf, axis=-1, keepdims=True) + NORM_EPS)
    return (y * g.astype(jnp.float32)).astype(x.dtype)


def swiglu(x, w_gate, w_up, w_down):
    return (jax.nn.silu(x @ w_gate) * (x @ w_up)) @ w_down


def rope_tables(seq_len):
    inv = 1.0 / (ROPE_THETA ** (jnp.arange(0, ROPE_DIM, 2, dtype=jnp.float32) / ROPE_DIM))
    ang = jnp.arange(seq_len, dtype=jnp.float32)[:, None] * inv[None, :]
    return jnp.cos(ang)[:, None, :], jnp.sin(ang)[:, None, :]


def apply_rope(x, cos, sin):
    xf = x.astype(jnp.float32)
    half = ROPE_DIM // 2
    x1, x2 = xf[..., :half], xf[..., half:]
    return jnp.concatenate([x1 * cos - x2 * sin, x1 * sin + x2 * cos], axis=-1).astype(x.dtype)


def mla_group(z_cq, z_ckv, z_kr, q_norm, w_uq, kv_norm, w_ukv, attn_out_norm):
    B, S, _ = z_cq.shape
    q = (rmsnorm(z_cq, q_norm) @ w_uq).reshape(B, S, ATT_HEADS, QK_DIM)
    kv = (rmsnorm(z_ckv, kv_norm) @ w_ukv).reshape(B, S, ATT_HEADS, NOPE_DIM + V_DIM)
    k_nope, v = kv[..., :NOPE_DIM], kv[..., NOPE_DIM:]
    cos, sin = rope_tables(S)
    q = jnp.concatenate([q[..., :NOPE_DIM], apply_rope(q[..., NOPE_DIM:], cos, sin)], axis=-1)
    k_pe = apply_rope(z_kr[:, :, None, :], cos, sin)
    k = jnp.concatenate([k_nope, jnp.broadcast_to(k_pe, (B, S, ATT_HEADS, ROPE_DIM))], axis=-1)
    q = q * (QK_DIM ** -0.5)
    q_blocks = q.reshape(B, S // Q_BLOCK, Q_BLOCK, ATT_HEADS, QK_DIM).transpose(1, 0, 2, 3, 4)

    def attend(qb):
        s = jnp.einsum('bqhd,bkhd->bhqk', qb, k, preferred_element_type=jnp.float32)
        p = jax.nn.softmax(s, axis=-1)
        return jnp.einsum('bhqk,bkhd->bqhd', p.astype(v.dtype), v)

    o = lax.map(attend, q_blocks)
    o = o.transpose(1, 0, 2, 3, 4).reshape(B, S, ATT_WIDTH)
    return rmsnorm(o, attn_out_norm)


def centred_shift(z, mu):
    z_prev = jnp.pad(z[:, :-1], ((0, 0), (1, 0), (0, 0)))
    z_next = jnp.pad(z[:, 1:], ((0, 0), (0, 1), (0, 0)))
    return z + mu[0] * (z_prev - z) + mu[1] * (z_next - z)


def wkv_scan(r, w, k, v, kk, b, reverse):
    B, S, H, N = r.shape
    seq = tuple(t.astype(jnp.float32).transpose(1, 0, 2, 3) for t in (r, w, k, v, kk, b))

    def step(state, inp):
        r_t, w_t, k_t, v_t, kk_t, b_t = inp
        sa = jnp.einsum('bhvk,bhk->bhv', state, kk_t)
        state = (state * w_t[:, :, None, :] - sa[..., None] * b_t[:, :, None, :]
                 + v_t[..., None] * k_t[:, :, None, :])
        return state, jnp.einsum('bhvk,bhk->bhv', state, r_t)

    s0 = jnp.zeros((B, H, N, N), jnp.float32)
    _, out = lax.scan(step, s0, seq, reverse=reverse)
    return out.transpose(1, 0, 2, 3)


def rwkv7_group(z, shift_mu, w0, w_up, a0, a_up, g_up, k_k, k_a, r_k, ln_w, ln_b):
    B, S, _ = z.shape
    hs = lambda t: t.reshape(B, S, RWKV_HEADS, RWKV_HEAD_DIM)
    z = centred_shift(z, shift_mu)
    r, k, v, wd_f, wd_b, ad_f, ad_b, gd = jnp.split(z, RWKV_SPLITS, axis=-1)
    g = jax.nn.sigmoid(gd) @ g_up
    kkf = hs(k * k_k).astype(jnp.float32)
    kk = kkf / jnp.maximum(jnp.sqrt(jnp.sum(kkf * kkf, axis=-1, keepdims=True)), 1e-12)
    y = jnp.zeros((B, S, RWKV_HEADS, RWKV_HEAD_DIM), jnp.float32)
    k_sum = jnp.zeros_like(k)
    for d, (wd, ad, rev) in enumerate(((wd_f, ad_f, False), (wd_b, ad_b, True))):
        w_log = -jax.nn.softplus(-(w0[d] + jnp.tanh(wd) @ w_up[d])) - 0.5
        decay = jnp.exp(-jnp.exp(w_log.astype(jnp.float32)))
        a = jax.nn.sigmoid(a0[d] + ad @ a_up[d])
        k_d = k * (1.0 + (a - 1.0) * k_a)
        y = y + wkv_scan(hs(r), hs(decay), hs(k_d), hs(v), kk, kk * hs(a).astype(jnp.float32), rev)
        k_sum = k_sum + k_d
    mean = jnp.mean(y, axis=-1, keepdims=True)
    var = jnp.mean(jnp.square(y - mean), axis=-1, keepdims=True)
    y = ((y - mean) * lax.rsqrt(var + LN_X_EPS)).reshape(B, S, RWKV_WIDTH)
    y = y * ln_w.astype(jnp.float32) + ln_b.astype(jnp.float32)
    bonus = jnp.sum((hs(r) * hs(k_sum) * r_k.reshape(RWKV_HEADS, RWKV_HEAD_DIM)).astype(jnp.float32),
                    axis=-1, keepdims=True) * hs(v).astype(jnp.float32)
    y = y + bonus.reshape(B, S, RWKV_WIDTH)
    return (y.astype(z.dtype)) * g


def encoder_layer(h, p):
    h = h + 0.5 * swiglu(rmsnorm(h, p['ffn1_norm']), p['ffn1_w_gate'], p['ffn1_w_up'], p['ffn1_w_down'])
    u = rmsnorm(h, p['mix_norm'])
    z = u @ p['w_in']
    att = mla_group(z[..., :OFF_CKV], z[..., OFF_CKV:OFF_KR], z[..., OFF_KR:OFF_RWKV],
                    p['q_norm'], p['w_uq'], p['kv_norm'], p['w_ukv'], p['attn_out_norm'])
    tm = rwkv7_group(z[..., OFF_RWKV:], p['shift_mu'], p['w0'], p['w_up'], p['a0'], p['a_up'],
                     p['g_up'], p['k_k'], p['k_a'], p['r_k'], p['ln_x_w'], p['ln_x_b'])
    h = h + jnp.concatenate([att, tm], axis=-1) @ p['w_out']
    h = h + 0.5 * swiglu(rmsnorm(h, p['ffn2_norm']), p['ffn2_w_gate'], p['ffn2_w_up'], p['ffn2_w_down'])
    return h


def setup_inputs(seed: int = 0) -> dict:
    key = jax.random.key(seed)
    ks = iter(jax.random.split(key, 40))
    nrm = lambda shape, s: jax.random.normal(next(ks), shape, jnp.float32) * s
    gain = lambda shape: 1.0 + nrm(shape, 0.05)
    L = DEPTH
    return {
        'x_prompt': nrm((BATCH, SEQ, D_MODEL), 1.0),
        'x_sample': nrm((DEC_BATCH, DEC_SEQ, D_MODEL), 1.0),
        'ffn1_norm': gain((L, D_MODEL)),
        'ffn1_w_gate': nrm((L, D_MODEL, D_FF), D_MODEL ** -0.5),
        'ffn1_w_up': nrm((L, D_MODEL, D_FF), D_MODEL ** -0.5),
        'ffn1_w_down': nrm((L, D_FF, D_MODEL), D_FF ** -0.5),
        'mix_norm': gain((L, D_MODEL)),
        'w_in': nrm((L, D_MODEL, IN_COLS), D_MODEL ** -0.5),
        'q_norm': gain((L, Q_RANK)),
        'w_uq': nrm((L, Q_RANK, ATT_HEADS * QK_DIM), Q_RANK ** -0.5),
        'kv_norm': gain((L, KV_RANK)),
        'w_ukv': nrm((L, KV_RANK, ATT_HEADS * (NOPE_DIM + V_DIM)), KV_RANK ** -0.5),
        'attn_out_norm': gain((L, ATT_WIDTH)),
        'shift_mu': jax.random.uniform(next(ks), (L, 2, RWKV_COLS), jnp.float32, 0.0, 0.5),
        'w0': nrm((L, 2, RWKV_WIDTH), 0.5),
        'w_up': nrm((L, 2, DECAY_LORA, RWKV_WIDTH), 0.1),
        'a0': nrm((L, 2, RWKV_WIDTH), 0.5),
        'a_up': nrm((L, 2, ICLR_LORA, RWKV_WIDTH), 0.1),
        'g_up': nrm((L, GATE_LORA, RWKV_WIDTH), GATE_LORA ** -0.5),
        'k_k': 0.85 + nrm((L, RWKV_WIDTH), 0.05),
        'k_a': gain((L, RWKV_WIDTH)),
        'r_k': nrm((L, RWKV_WIDTH), 0.1),
        'ln_x_w': gain((L, RWKV_WIDTH)),
        'ln_x_b': nrm((L, RWKV_WIDTH), 0.01),
        'w_out': nrm((L, MIX_WIDTH, D_MODEL), MIX_WIDTH ** -0.5),
        'ffn2_norm': gain((L, D_MODEL)),
        'ffn2_w_gate': nrm((L, D_MODEL, D_FF), D_MODEL ** -0.5),
        'ffn2_w_up': nrm((L, D_MODEL, D_FF), D_MODEL ** -0.5),
        'ffn2_w_down': nrm((L, D_FF, D_MODEL), D_FF ** -0.5),
        'final_norm': gain((D_MODEL,)),
    }


def reference(x_prompt, x_sample, ffn1_norm, ffn1_w_gate, ffn1_w_up, ffn1_w_down, mix_norm, w_in,
              q_norm, w_uq, kv_norm, w_ukv, attn_out_norm, shift_mu, w0, w_up, a0, a_up, g_up,
              k_k, k_a, r_k, ln_x_w, ln_x_b, w_out, ffn2_norm, ffn2_w_gate, ffn2_w_up, ffn2_w_down,
              final_norm):
    def trunk(x):
        h = x
        for i in range(DEPTH):
            p = {
                'ffn1_norm': ffn1_norm[i], 'ffn1_w_gate': ffn1_w_gate[i], 'ffn1_w_up': ffn1_w_up[i],
                'ffn1_w_down': ffn1_w_down[i], 'mix_norm': mix_norm[i], 'w_in': w_in[i],
                'q_norm': q_norm[i], 'w_uq': w_uq[i], 'kv_norm': kv_norm[i], 'w_ukv': w_ukv[i],
                'attn_out_norm': attn_out_norm[i], 'shift_mu': shift_mu[i], 'w0': w0[i],
                'w_up': w_up[i], 'a0': a0[i], 'a_up': a_up[i], 'g_up': g_up[i], 'k_k': k_k[i],
                'k_a': k_a[i], 'r_k': r_k[i], 'ln_x_w': ln_x_w[i], 'ln_x_b': ln_x_b[i],
                'w_out': w_out[i], 'ffn2_norm': ffn2_norm[i], 'ffn2_w_gate': ffn2_w_gate[i],
                'ffn2_w_up': ffn2_w_up[i], 'ffn2_w_down': ffn2_w_down[i],
            }
            h = encoder_layer(h, p)
        return rmsnorm(h, final_norm)

    y_prompt = trunk(x_prompt)
    y_sample = trunk(x_sample)
    return (y_prompt, y_sample)
```

```cpp
#include <hip/hip_runtime.h>
#include <hip/hip_cooperative_groups.h>
#include <hip/hip_bf16.h>
#include <cstdio>
#include <cstdint>
namespace cg = cooperative_groups;
namespace pg8 {
#define PG8_LAS __attribute__((address_space(3)))
typedef unsigned short bf16_t;
typedef short bf16x8 __attribute__((ext_vector_type(8)));
typedef float f32x4 __attribute__((ext_vector_type(4)));
typedef unsigned u32x4 __attribute__((ext_vector_type(4)));
constexpr int BM = 256, BK = 64, HALF = 128, HTB = HALF * BK * 2  , STAGE_BYTES = 8 * HTB, NXCD = 8, WGM = 8;

__host__ __device__ __forceinline__ int lds_byte(int r, int c) { const int st = (r >> 4) * 2 + (c >> 5), rr = r & 15, cc = c & 31, ob = rr * 64 + cc * 2; return st * 1024 + (ob ^ (((ob >> 9) & 1) << 5)); }
__host__ __device__ __forceinline__ void stage_rc(int b, int& R, int& C) { const int st = b / 1024, sb = b % 1024, swz = sb ^ (((sb >> 9) & 1) << 5); R = (st >> 1) * 16 + swz / 64; C = (st & 1) * 32 + (swz % 64) / 2; }
__host__ __device__ __forceinline__ int perm32(int rho) { const int n = rho >> 4, i = rho & 15; return 8 * (i >> 2) + 4 * n + (i & 3); }

struct Unit { int pm, pn; };
struct Gemm { const bf16_t* A; const bf16_t* Bt; int M, N, K, lda; };

struct StaticOrder {
    int nM, nN, nwg, G, c;
    __host__ __device__ void init(int M, int N, int G_, int c_) { nM = M / BM; nN = N / BM; nwg = nM * nN; G = G_; c = c_; }
    __host__ __device__ bool next(int i, Unit& u) const {
        const long L = (long)i * G + c; if (L >= nwg) return false;
        int wgid = (int)L; { const int q = nwg / NXCD, r = nwg % NXCD, xcd = wgid % NXCD, off = wgid / NXCD; wgid = (xcd < r ? xcd * (q + 1) : r * (q + 1) + (xcd - r) * q) + off; }
        const int nig = WGM * nN, gid = wgid / nig, fm = gid * WGM, gsz = (nM - fm) < WGM ? (nM - fm) : WGM;
        u.pm = fm + ((wgid % nig) % gsz); u.pn = (wgid % nig) / gsz; return true;
    }
    __device__ __forceinline__ void a_ready(const Unit&) const {}
    __device__ __forceinline__ void done(const Unit&) const {}
};

__device__ __forceinline__ unsigned cvt_pk_bf16(float lo, float hi) { unsigned r; asm volatile("v_cvt_pk_bf16_f32 %0, %1, %2" : "=v"(r) : "v"(lo), "v"(hi)); return r; }
typedef float f32x2 __attribute__((ext_vector_type(2)));
template <class Epi, class Sched, bool ALIGN_EPI = false, bool SP2 = false>
__device__ __forceinline__ void gemm_phase(PG8_LAS unsigned char* lds, const Gemm g, const Sched& S, const Epi& E) {
    int tid_ = threadIdx.x; asm volatile("" : "+v"(tid_));
    const int tid = tid_, wid = __builtin_amdgcn_readfirstlane(tid >> 6), lane = tid & 63, wr = wid >> 2, wc = wid & 3, fr = lane & 15, fq = lane >> 4;
    int K_ = g.K; asm volatile("" : "+s"(K_));
    const int K = K_, nt = K / BK;
    unsigned voffA[2], voffB[2];
#pragma unroll
    for (int i = 0; i < 2; ++i) { int R, C; stage_rc(tid * 16 + i * 8192, R, C); const int Rb = Epi::PERM ? ((R & ~31) + perm32(R & 31)) : R;
        voffA[i] = (unsigned)(R * g.lda + C) * 2u; voffB[i] = (unsigned)(Rb * K + C) * 2u; }
    const size_t kstep = (size_t)(BK * 2);
    const size_t hstepB = (size_t)HALF * K * 2, hstepA = (size_t)HALF * g.lda * 2;
    const size_t tstepA = 2 * hstepA, tstepB = 2 * hstepB;
    const unsigned ldsw = (unsigned)wid * 1024u;
    const int aoff = lds_byte(wr * 64 + fr, fq * 8), boff = lds_byte(wc * 32 + fr, fq * 8);
#define PG8_SA(b, h) (((b) * 2 + (h)) * HTB)
#define PG8_SB(b, h) ((4 + (b) * 2 + (h)) * HTB)
#define PG8_STAGE(bufoff, gbase, voff) do { _Pragma("unroll") for (int _i = 0; _i < 2; ++_i) \
        __builtin_amdgcn_global_load_lds((const unsigned*)((const char*)(gbase) + (voff)[_i]), (PG8_LAS unsigned*)(lds + (bufoff) + ldsw + _i * 8192), 16, 0, 0); } while (0)
#define PG8_LDA(dst, b, h) do { _Pragma("unroll") for (int m = 0; m < 4; ++m) _Pragma("unroll") for (int k = 0; k < 2; ++k) dst[m][k] = *(const PG8_LAS bf16x8*)(lds + PG8_SA(b, h) + aoff + m * 2048 + k * 1024); } while (0)
#define PG8_LDB(dst, b, h) do { _Pragma("unroll") for (int n = 0; n < 2; ++n) _Pragma("unroll") for (int k = 0; k < 2; ++k) dst[n][k] = *(const PG8_LAS bf16x8*)(lds + PG8_SB(b, h) + boff + n * 2048 + k * 1024); } while (0)
#define PG8_MMA(ai, bj, At, Bt) do { __builtin_amdgcn_s_setprio(1); _Pragma("unroll") for (int m = 0; m < 4; ++m) _Pragma("unroll") for (int n = 0; n < 2; ++n) _Pragma("unroll") for (int k = 0; k < 2; ++k) \
        acc[ai][bj][m][n] = __builtin_amdgcn_mfma_f32_16x16x32_bf16(Bt[n][k], At[m][k], acc[ai][bj][m][n], 0, 0, 0); __builtin_amdgcn_s_setprio(0); } while (0)
#define PG8_WAIT_V(n) asm volatile("s_waitcnt vmcnt(" #n ")" ::: "memory")
#define PG8_WAIT_L(n) asm volatile("s_waitcnt lgkmcnt(" #n ")" ::: "memory")
#define PG8_BAR __builtin_amdgcn_s_barrier()
#define PG8_SCHED __builtin_amdgcn_sched_barrier(0)
    Unit cur, nxt; int ui = 0;
    if (!S.next(0, cur)) return;
    f32x4 acc[2][2][4][2];
#pragma unroll
    for (int a = 0; a < 2; ++a)
#pragma unroll
        for (int b = 0; b < 2; ++b)
#pragma unroll
            for (int m = 0; m < 4; ++m)
#pragma unroll
                for (int n = 0; n < 2; ++n) acc[a][b][m][n] = (f32x4){0.f, 0.f, 0.f, 0.f};
    bf16x8 At[4][2], B0[2][2], B1[2][2];
    const char* cA = (const char*)g.A + (size_t)cur.pm * tstepA; const char* cB = (const char*)g.Bt + (size_t)cur.pn * tstepB;
    S.a_ready(cur);
    if constexpr (SP2) {
        PG8_STAGE(PG8_SB(0, 0), cB, voffB); PG8_STAGE(PG8_SB(0, 1), cB + hstepB, voffB); PG8_STAGE(PG8_SA(0, 0), cA, voffA); PG8_STAGE(PG8_SA(0, 1), cA + hstepA, voffA);
        if (wr == 1) PG8_BAR;
        PG8_WAIT_V(2); PG8_BAR;
        PG8_STAGE(PG8_SB(1, 0), cB + kstep, voffB); PG8_STAGE(PG8_SA(1, 0), cA + kstep, voffA); PG8_STAGE(PG8_SB(1, 1), cB + hstepB + kstep, voffB);
        PG8_WAIT_V(6); PG8_BAR;
    } else {
        PG8_STAGE(PG8_SB(0, 0), cB, voffB); PG8_STAGE(PG8_SA(0, 0), cA, voffA); PG8_STAGE(PG8_SB(0, 1), cB + hstepB, voffB); PG8_STAGE(PG8_SA(0, 1), cA + hstepA, voffA);
        if (wr == 1) PG8_BAR;
        PG8_WAIT_V(4); PG8_BAR;
        PG8_STAGE(PG8_SB(1, 0), cB + kstep, voffB); PG8_STAGE(PG8_SA(1, 0), cA + kstep, voffA); PG8_STAGE(PG8_SB(1, 1), cB + hstepB + kstep, voffB);
        PG8_WAIT_V(6); PG8_BAR;
    }
    for (;;) {
        const bool has_next = S.next(ui + 1, nxt);
        const char* nA = has_next ? (const char*)g.A + (size_t)nxt.pm * tstepA : cA; const char* nB = has_next ? (const char*)g.Bt + (size_t)nxt.pn * tstepB : cB;
        for (int t = 0; t < nt; t += 2) {
            const bool last = (t == nt - 2);
            const char* a1 = cA + (size_t)(t + 1) * kstep;
            const char* a2 = last ? nA : cA + (size_t)(t + 2) * kstep; const char* b2 = last ? nB : cB + (size_t)(t + 2) * kstep;
            const char* a3 = a2 + kstep; const char* b3 = b2 + kstep;
            if (last && has_next) S.a_ready(nxt);
            if constexpr (SP2) {
            PG8_LDB(B0, 0, 0); PG8_LDB(B1, 0, 1); PG8_SCHED; PG8_LDA(At, 0, 0); PG8_STAGE(PG8_SA(1, 1), a1 + hstepA, voffA);
            PG8_WAIT_V(8); PG8_WAIT_L(0); PG8_BAR; PG8_MMA(0, 0, At, B0); PG8_MMA(0, 1, At, B1); PG8_BAR; PG8_SCHED;
            PG8_LDA(At, 0, 1); PG8_STAGE(PG8_SB(0, 0), b2, voffB); PG8_STAGE(PG8_SB(0, 1), b2 + hstepB, voffB); PG8_STAGE(PG8_SA(0, 0), a2, voffA);
            PG8_WAIT_V(8); PG8_WAIT_L(0); PG8_BAR; PG8_MMA(1, 0, At, B0); PG8_MMA(1, 1, At, B1); PG8_BAR; PG8_SCHED;
            PG8_LDB(B0, 1, 0); PG8_LDB(B1, 1, 1); PG8_SCHED; PG8_LDA(At, 1, 0); PG8_STAGE(PG8_SA(0, 1), a2 + hstepA, voffA);
            PG8_WAIT_V(8); PG8_WAIT_L(0); PG8_BAR; PG8_MMA(0, 0, At, B0); PG8_MMA(0, 1, At, B1); PG8_BAR; PG8_SCHED;
            PG8_LDA(At, 1, 1); PG8_STAGE(PG8_SB(1, 0), b3, voffB); PG8_STAGE(PG8_SB(1, 1), b3 + hstepB, voffB); PG8_STAGE(PG8_SA(1, 0), a3, voffA);
            PG8_WAIT_V(8); PG8_WAIT_L(0); PG8_BAR; PG8_MMA(1, 0, At, B0); PG8_MMA(1, 1, At, B1); PG8_BAR; PG8_SCHED;
            } else {
            PG8_LDB(B0, 0, 0); PG8_SCHED; PG8_LDA(At, 0, 0); PG8_STAGE(PG8_SA(1, 1), a1 + hstepA, voffA);
            PG8_WAIT_L(8); PG8_BAR; PG8_WAIT_L(0); PG8_MMA(0, 0, At, B0); PG8_BAR; PG8_SCHED;
            PG8_LDB(B1, 0, 1); PG8_STAGE(PG8_SB(0, 0), b2, voffB);
            PG8_BAR; PG8_WAIT_L(0); PG8_MMA(0, 1, At, B1); PG8_BAR;
            PG8_LDA(At, 0, 1); PG8_STAGE(PG8_SA(0, 0), a2, voffA);
            PG8_BAR; PG8_WAIT_L(0); PG8_MMA(1, 0, At, B0); PG8_BAR; PG8_SCHED;
            PG8_STAGE(PG8_SB(0, 1), b2 + hstepB, voffB);
            PG8_WAIT_V(6); PG8_BAR; PG8_MMA(1, 1, At, B1); PG8_BAR;
            PG8_LDB(B0, 1, 0); PG8_SCHED; PG8_LDA(At, 1, 0); PG8_STAGE(PG8_SA(0, 1), a2 + hstepA, voffA);
            PG8_WAIT_L(8); PG8_BAR; PG8_WAIT_L(0); PG8_MMA(0, 0, At, B0); PG8_BAR; PG8_SCHED;
            PG8_LDB(B1, 1, 1); PG8_STAGE(PG8_SB(1, 0), b3, voffB);
            PG8_BAR; PG8_WAIT_L(0); PG8_MMA(0, 1, At, B1); PG8_BAR;
            PG8_LDA(At, 1, 1); PG8_STAGE(PG8_SA(1, 0), a3, voffA);
            PG8_BAR; PG8_WAIT_L(0); PG8_MMA(1, 0, At, B0); PG8_BAR; PG8_SCHED;
            PG8_STAGE(PG8_SB(1, 1), b3 + hstepB, voffB);
            PG8_WAIT_V(6); PG8_BAR; PG8_MMA(1, 1, At, B1); PG8_BAR;
            }
        }
        if constexpr (ALIGN_EPI) { if (wr == 0) PG8_BAR; }
        if constexpr (!Epi::AFTER_DRAIN) { E(acc, cur, wr, wc, fr, fq); S.done(cur); }
        if (!has_next) break;
#pragma unroll
        for (int a = 0; a < 2; ++a)
#pragma unroll
            for (int b = 0; b < 2; ++b)
#pragma unroll
                for (int m = 0; m < 4; ++m)
#pragma unroll
                    for (int n = 0; n < 2; ++n) acc[a][b][m][n] = (f32x4){0.f, 0.f, 0.f, 0.f};
        cur = nxt; cA = nA; cB = nB; ++ui;
        if constexpr (ALIGN_EPI) { if (wr == 1) PG8_BAR; }
    }
    PG8_WAIT_V(0);
    if constexpr (!ALIGN_EPI) { if (wr == 0) PG8_BAR; }
    PG8_BAR;
    if constexpr (Epi::AFTER_DRAIN) { E.fused(acc, cur, wr, wc, fr, fq, lds, wid, lane); S.done(cur); }
#undef PG8_SA
#undef PG8_SB
#undef PG8_STAGE
#undef PG8_LDA
#undef PG8_LDB
#undef PG8_MMA
#undef PG8_WAIT_V
#undef PG8_WAIT_L
#undef PG8_BAR
#undef PG8_SCHED
}
}

#define LAS __attribute__((address_space(3)))
typedef unsigned short bf16_t;
typedef float f32x4 __attribute__((ext_vector_type(4)));
typedef unsigned u32x4 __attribute__((ext_vector_type(4)));
typedef unsigned u32x2 __attribute__((ext_vector_type(2)));
typedef _Float16 h16x2 __attribute__((ext_vector_type(2)));
constexpr int DM = 1024, TP = 32768, TS = 16384, T = TP + TS, DFF = 2816, NH = 8;
constexpr float NORM_EPS = 1e-6f, LNX_EPS = 64e-5f;
constexpr size_t MiB = 1u << 20;
constexpr size_t WS_CTL = 0, WS_WL = 1 * MiB, WS_ZERO_BYTES = 3 * MiB, WS_ROPE = 3 * MiB;
constexpr size_t WS_WGU1 = 5 * MiB, WS_WD1 = 16 * MiB, WS_WGU2 = 21 * MiB + MiB / 2, WS_WD2 = 32 * MiB + MiB / 2, WS_WIN = 38 * MiB,
                 WS_WUQ = 43 * MiB + MiB / 2, WS_WUKV = WS_WUQ + 9 * MiB / 16, WS_WOUT = WS_WUKV + MiB / 2;
constexpr size_t WS_D1 = 48 * MiB, WS_ZRKV = 144 * MiB, WS_ZA = 288 * MiB, WS_ZL = 360 * MiB, WS_U = 408 * MiB, WS_END = 512 * MiB;
constexpr size_t WS_ACT = 144 * MiB, WS_MIX = 288 * MiB, WS_LIN = 408 * MiB, WS_Y = 408 * MiB;
constexpr size_t WS_BAR = 512 * 1024;
constexpr size_t WS_SMID = 0, WS_QC0 = 384 * MiB, WS_QC1 = 504 * MiB;
constexpr size_t WS_BS = 1 * MiB;
constexpr size_t DO_Q = 0, DO_K = 72 * MiB, DO_V = 144 * MiB, DO_WA = 0;
static_assert(WS_WOUT + 2 * MiB <= WS_D1, "weights overflow");
constexpr int LDS_BYTES = 147456;

__device__ const float ROPE_INV[16] = {1.000000000e+00f, 5.623413324e-01f, 3.162277639e-01f, 1.778279394e-01f, 1.000000015e-01f, 5.623412877e-02f, 3.162277862e-02f, 1.778279431e-02f,
                                       9.999999776e-03f, 5.623413250e-03f, 3.162277862e-03f, 1.778279431e-03f, 1.000000047e-03f, 5.623413017e-04f, 3.162277862e-04f, 1.778279402e-04f};

__device__ __forceinline__ float bflo(unsigned w) { return __uint_as_float(w << 16); }
__device__ __forceinline__ float bfhi(unsigned w) { return __uint_as_float(w & 0xffff0000u); }
__device__ __forceinline__ unsigned pkbf(float lo, float hi) { return pg8::cvt_pk_bf16(lo, hi); }
__device__ __forceinline__ unsigned pkh(float lo, float hi) { h16x2 v; v.x = (_Float16)lo; v.y = (_Float16)hi; return __builtin_bit_cast(unsigned, v); }
__device__ __forceinline__ float hlo(unsigned w) { h16x2 v = __builtin_bit_cast(h16x2, w); return (float)v.x; }
__device__ __forceinline__ float hhi(unsigned w) { h16x2 v = __builtin_bit_cast(h16x2, w); return (float)v.y; }
__device__ __forceinline__ void unpack8bf(const u32x4 w, float* f) { f[0] = bflo(w.x); f[1] = bfhi(w.x); f[2] = bflo(w.y); f[3] = bfhi(w.y); f[4] = bflo(w.z); f[5] = bfhi(w.z); f[6] = bflo(w.w); f[7] = bfhi(w.w); }
__device__ __forceinline__ void unpack8h(const u32x4 w, float* f) { f[0] = hlo(w.x); f[1] = hhi(w.x); f[2] = hlo(w.y); f[3] = hhi(w.y); f[4] = hlo(w.z); f[5] = hhi(w.z); f[6] = hlo(w.w); f[7] = hhi(w.w); }
__device__ __forceinline__ float wave_sum(float v) {
#pragma unroll
    for (int o = 1; o < 64; o <<= 1) v += __shfl_xor(v, o);
    return v;
}
__device__ __forceinline__ float fsigmoid(float x) { return __builtin_amdgcn_rcpf(1.f + __builtin_amdgcn_exp2f(-1.4426950408889634f * x)); }
__device__ __forceinline__ int seq_pos(int row) { return row < TP ? (row & 8191) : (row - TP); }

using pg8::Unit;
typedef const pg8::f32x4 (&AccRef)[2][2][4][2];

struct EpiSwiGLU {
    static constexpr bool PERM = true, AFTER_DRAIN = false; bf16_t* O;
    __device__ __forceinline__ void operator()(AccRef acc, const Unit& u, int wr, int wc, int fr, int fq) const {
        asm volatile("" : "+v"(fr), "+v"(fq));
        const int row0 = u.pm * 256 + wr * 64 + fr, col0 = u.pn * 128 + wc * 32 + 8 * fq;
#pragma unroll
        for (int ai = 0; ai < 2; ++ai)
#pragma unroll
            for (int m = 0; m < 4; ++m) {
                bf16_t* rowp = O + (size_t)(row0 + ai * 128 + m * 16) * DFF + col0;
                float o[8];
#pragma unroll
                for (int n = 0; n < 2; ++n)
#pragma unroll
                    for (int e = 0; e < 4; ++e) { const float g = acc[ai][0][m][n][e], up = acc[ai][1][m][n][e]; o[n * 4 + e] = g * fsigmoid(g) * up; }
                u32x4 w; w.x = pkbf(o[0], o[1]); w.y = pkbf(o[2], o[3]); w.z = pkbf(o[4], o[5]); w.w = pkbf(o[6], o[7]);
                *(u32x4*)rowp = w; __builtin_amdgcn_sched_barrier(0); asm volatile("" ::: "memory");
            }
    }
};
struct EpiScaleBf16 {
    static constexpr bool PERM = true, AFTER_DRAIN = false; bf16_t* O; float s;
    __device__ __forceinline__ void operator()(AccRef acc, const Unit& u, int wr, int wc, int fr, int fq) const {
        asm volatile("" : "+v"(fr), "+v"(fq));
        const int row0 = u.pm * 256 + wr * 64 + fr, col0 = u.pn * 256 + wc * 32 + 8 * fq;
#pragma unroll
        for (int ai = 0; ai < 2; ++ai)
#pragma unroll
            for (int m = 0; m < 4; ++m)
#pragma unroll
                for (int bj = 0; bj < 2; ++bj) {
                    const pg8::f32x4 v0 = acc[ai][bj][m][0] * s, v1 = acc[ai][bj][m][1] * s;
                    u32x4 w; w.x = pkbf(v0[0], v0[1]); w.y = pkbf(v0[2], v0[3]); w.z = pkbf(v1[0], v1[1]); w.w = pkbf(v1[2], v1[3]);
                    *(u32x4*)(O + (size_t)(row0 + ai * 128 + m * 16) * DM + col0 + bj * 128) = w; __builtin_amdgcn_sched_barrier(0); asm volatile("" ::: "memory");
                }
    }
};
struct EpiZ {
    static constexpr bool PERM = true, AFTER_DRAIN = false; bf16_t *ZA, *ZRKV, *ZL;
    __device__ __forceinline__ void operator()(AccRef acc, const Unit& u, int wr, int wc, int fr, int fq) const {
        asm volatile("" : "+v"(fr), "+v"(fq));
        bf16_t* base; int ldc, colt;
        if (u.pn < 3) { base = ZA; ldc = 768; colt = u.pn * 256; } else if (u.pn < 9) { base = ZRKV; ldc = 1536; colt = (u.pn - 3) * 256; } else { base = ZL; ldc = 512; colt = (u.pn - 9) * 256; }
        const int row0 = u.pm * 256 + wr * 64 + fr, col0 = colt + wc * 32 + 8 * fq;
#pragma unroll
        for (int ai = 0; ai < 2; ++ai)
#pragma unroll
            for (int m = 0; m < 4; ++m)
#pragma unroll
                for (int bj = 0; bj < 2; ++bj) {
                    const pg8::f32x4 v0 = acc[ai][bj][m][0], v1 = acc[ai][bj][m][1];
                    u32x4 w; w.x = pkbf(v0[0], v0[1]); w.y = pkbf(v0[2], v0[3]); w.z = pkbf(v1[0], v1[1]); w.w = pkbf(v1[2], v1[3]);
                    *(u32x4*)(base + (size_t)(row0 + ai * 128 + m * 16) * ldc + col0 + bj * 128) = w; __builtin_amdgcn_sched_barrier(0); asm volatile("" ::: "memory");
                }
    }
};
struct EpiPlain {
    static constexpr bool PERM = true, AFTER_DRAIN = false; bf16_t* O; int ldc;
    __device__ __forceinline__ void operator()(AccRef acc, const Unit& u, int wr, int wc, int fr, int fq) const {
        asm volatile("" : "+v"(fr), "+v"(fq));
        const int row0 = u.pm * 256 + wr * 64 + fr, col0 = u.pn * 256 + wc * 32 + 8 * fq;
#pragma unroll
        for (int ai = 0; ai < 2; ++ai)
#pragma unroll
            for (int m = 0; m < 4; ++m)
#pragma unroll
                for (int bj = 0; bj < 2; ++bj) {
                    const pg8::f32x4 v0 = acc[ai][bj][m][0], v1 = acc[ai][bj][m][1];
                    u32x4 w; w.x = pkbf(v0[0], v0[1]); w.y = pkbf(v0[2], v0[3]); w.z = pkbf(v1[0], v1[1]); w.w = pkbf(v1[2], v1[3]);
                    *(u32x4*)(O + (size_t)(row0 + ai * 128 + m * 16) * ldc + col0 + bj * 128) = w;
                }
    }
};
struct EpiKV {
    static constexpr bool PERM = true, AFTER_DRAIN = false; bf16_t *K, *V;
    __device__ __forceinline__ void operator()(AccRef acc, const Unit& u, int wr, int wc, int fr, int fq) const {
        asm volatile("" : "+v"(fr), "+v"(fq));
        const int row0 = u.pm * 256 + wr * 64 + fr;
        const bool isk = u.pn < 2; bf16_t* base = isk ? K : V; const int ldc = isk ? 768 : 512;
#pragma unroll
        for (int bj = 0; bj < 2; ++bj) {
            const int c0 = (u.pn & 1) * 256 + bj * 128 + wc * 32 + 8 * fq;
            const int cc = isk ? (c0 >> 6) * 96 + (c0 & 63) : c0;
#pragma unroll
            for (int ai = 0; ai < 2; ++ai)
#pragma unroll
                for (int m = 0; m < 4; ++m) {
                    const pg8::f32x4 v0 = acc[ai][bj][m][0], v1 = acc[ai][bj][m][1];
                    u32x4 w; w.x = pkbf(v0[0], v0[1]); w.y = pkbf(v0[2], v0[3]); w.z = pkbf(v1[0], v1[1]); w.w = pkbf(v1[2], v1[3]);
                    *(u32x4*)(base + (size_t)(row0 + ai * 128 + m * 16) * ldc + cc) = w;
                }
        }
    }
};
struct EpiLora {
    static constexpr bool PERM = true, AFTER_DRAIN = false; unsigned short* WA; bf16_t* MIX; const float *w0, *a0; int seg0;
    template <int MODE> __device__ __forceinline__ void run(AccRef acc, const Unit& u, int wr, int wc, int fr, int fq) const {
        const int row0 = u.pm * 256 + wr * 64 + fr, seg = seg0 + (u.pn >> 1);
#pragma unroll
        for (int bj = 0; bj < 2; ++bj) {
            const int cc = (u.pn & 1) * 256 + bj * 128 + wc * 32 + 8 * fq;
            float bias[8];
            if (MODE < 2) { const float* bp = (MODE == 0 ? w0 + seg * 512 : a0 + (seg - 2) * 512) + cc; const f32x4 b0 = *(const f32x4*)bp, b1 = *(const f32x4*)(bp + 4);
                bias[0] = b0[0]; bias[1] = b0[1]; bias[2] = b0[2]; bias[3] = b0[3]; bias[4] = b1[0]; bias[5] = b1[1]; bias[6] = b1[2]; bias[7] = b1[3]; }
            else {
#pragma unroll
                for (int e = 0; e < 8; ++e) bias[e] = 0.f; }
#pragma unroll
            for (int ai = 0; ai < 2; ++ai)
#pragma unroll
                for (int m = 0; m < 4; ++m) {
                    const int row = row0 + ai * 128 + m * 16;
                    float x[8];
#pragma unroll
                    for (int e = 0; e < 4; ++e) { x[e] = acc[ai][bj][m][0][e] + bias[e]; x[4 + e] = acc[ai][bj][m][1][e] + bias[4 + e]; }
                    u32x4 w;
                    if (MODE == 0) {
#pragma unroll
                        for (int e = 0; e < 8; ++e) { const float sp = __logf(1.f + __expf(-x[e])); x[e] = __expf(-__expf(-sp - 0.5f)); }
                        w.x = pkh(x[0], x[1]); w.y = pkh(x[2], x[3]); w.z = pkh(x[4], x[5]); w.w = pkh(x[6], x[7]);
                        *(u32x4*)(WA + (size_t)row * 2048 + seg * 512 + cc) = w;
                    } else if (MODE == 1) {
#pragma unroll
                        for (int e = 0; e < 8; ++e) x[e] = fsigmoid(x[e]);
                        w.x = pkh(x[0], x[1]); w.y = pkh(x[2], x[3]); w.z = pkh(x[4], x[5]); w.w = pkh(x[6], x[7]);
                        *(u32x4*)(WA + (size_t)row * 2048 + seg * 512 + cc) = w;
                    } else {
                        w.x = pkbf(x[0], x[1]); w.y = pkbf(x[2], x[3]); w.z = pkbf(x[4], x[5]); w.w = pkbf(x[6], x[7]);
                        *(u32x4*)(MIX + (size_t)row * 1024 + 512 + cc) = w;
                    }
                    __builtin_amdgcn_sched_barrier(0); asm volatile("" ::: "memory");
                }
        }
    }
    __device__ __forceinline__ void operator()(AccRef acc, const Unit& u, int wr, int wc, int fr, int fq) const {
        asm volatile("" : "+v"(fr), "+v"(fq));
        const int seg = seg0 + (u.pn >> 1);
        if (seg < 2) run<0>(acc, u, wr, wc, fr, fq); else if (seg < 4) run<1>(acc, u, wr, wc, fr, fq); else run<2>(acc, u, wr, wc, fr, fq);
    }
};
struct EpiOut {
    static constexpr bool PERM = true, AFTER_DRAIN = false; const float *xp, *xs; bf16_t* D1;
    __device__ __forceinline__ void operator()(AccRef acc, const Unit& u, int wr, int wc, int fr, int fq) const {
        asm volatile("" : "+v"(fr), "+v"(fq));
        const int row0 = u.pm * 256 + wr * 64 + fr, col0 = u.pn * 256 + wc * 32 + 8 * fq;
        const float* xb = (u.pm * 256 < TP) ? xp : xs - (size_t)TP * DM;
#pragma unroll
        for (int ai = 0; ai < 2; ++ai)
#pragma unroll
            for (int m = 0; m < 4; ++m)
#pragma unroll
                for (int bj = 0; bj < 2; ++bj) {
                    const size_t off = (size_t)(row0 + ai * 128 + m * 16) * DM + col0 + bj * 128;
                    const f32x4 x0 = *(const f32x4*)(xb + off), x1 = *(const f32x4*)(xb + off + 4);
                    const u32x4 dw = *(const u32x4*)(D1 + off); float d[8]; unpack8bf(dw, d);
                    float o[8];
#pragma unroll
                    for (int e = 0; e < 4; ++e) { o[e] = x0[e] + d[e] + acc[ai][bj][m][0][e]; o[4 + e] = x1[e] + d[4 + e] + acc[ai][bj][m][1][e]; }
                    u32x4 w; w.x = pkbf(o[0], o[1]); w.y = pkbf(o[2], o[3]); w.z = pkbf(o[4], o[5]); w.w = pkbf(o[6], o[7]);
                    *(u32x4*)(D1 + off) = w;
                }
    }
};
struct EpiDown2 {
    static constexpr bool PERM = true, AFTER_DRAIN = false; bf16_t* Hb;
    __device__ __forceinline__ void operator()(AccRef acc, const Unit& u, int wr, int wc, int fr, int fq) const {
        asm volatile("" : "+v"(fr), "+v"(fq));
        const int row0 = u.pm * 256 + wr * 64 + fr, col0 = u.pn * 256 + wc * 32 + 8 * fq;
#pragma unroll
        for (int ai = 0; ai < 2; ++ai)
#pragma unroll
            for (int m = 0; m < 4; ++m)
#pragma unroll
                for (int bj = 0; bj < 2; ++bj) {
                    const size_t off = (size_t)(row0 + ai * 128 + m * 16) * DM + col0 + bj * 128;
                    const u32x4 hw = *(const u32x4*)(Hb + off); float h[8]; unpack8bf(hw, h);
#pragma unroll
                    for (int e = 0; e < 4; ++e) { h[e] += 0.5f * acc[ai][bj][m][0][e]; h[4 + e] += 0.5f * acc[ai][bj][m][1][e]; }
                    u32x4 w; w.x = pkbf(h[0], h[1]); w.y = pkbf(h[2], h[3]); w.z = pkbf(h[4], h[5]); w.w = pkbf(h[6], h[7]);
                    *(u32x4*)(Hb + off) = w;
                }
    }
};

__device__ __forceinline__ void transpose_item(const float* W, int N, int k0, int n0, bf16_t* WT, int ldk, int kdst0, int drow0, bool ropeperm, LAS float* scr, int lane, float sc = 1.f) {
#pragma unroll 8
    for (int i = 0; i < 32; ++i) { const int kk = 2 * i + (lane >> 5); scr[kk * 33 + (lane & 31)] = W[(size_t)(k0 + kk) * N + n0 + (lane & 31)]; }
    asm volatile("s_waitcnt lgkmcnt(0)" ::: "memory");
    const int c = lane & 7;
#pragma unroll
    for (int j = 0; j < 4; ++j) { const int n = (lane >> 3) + 8 * j; const LAS float* s = scr + (8 * c) * 33 + n;
        u32x4 o; o.x = pkbf(s[0 * 33] * sc, s[1 * 33] * sc); o.y = pkbf(s[2 * 33] * sc, s[3 * 33] * sc); o.z = pkbf(s[4 * 33] * sc, s[5 * 33] * sc); o.w = pkbf(s[6 * 33] * sc, s[7 * 33] * sc);
        const int dn = ropeperm ? (n < 16 ? 2 * n : 2 * (n - 16) + 1) : n;
        *(u32x4*)(WT + (size_t)(drow0 + dn) * ldk + kdst0 + k0 + 8 * c) = o; }
    asm volatile("s_waitcnt lgkmcnt(0)" ::: "memory");
}

struct Args { const float* in[30]; float* out; unsigned char* ws; };
typedef Args P;
__device__ __forceinline__ const float* xrow(const P& p, int row) { return row < TP ? p.in[0] + (size_t)row * DM : p.in[1] + (size_t)(row - TP) * DM; }

__device__ __forceinline__ void prologue(const P& p, LAS unsigned char* lds, int gw, int NGW, int wave, int lane, int gtid, int GT, int which) {
    LAS float* scr = (LAS float*)(lds + wave * 16384);
    unsigned char* ws = p.ws;
    constexpr int I_G = 16 * 88, I_D = 44 * 32, I_IN = 16 * 81, I_UQ = 6 * 24, I_UKV = 4 * 32, I_OUT = 16 * 32, I_L = 16, I_GL = 2 * 16;
    constexpr int NITEMS = 4 * I_G + 2 * I_D + I_IN + I_UQ + I_UKV + I_OUT + 4 * I_L + I_GL;
    for (int it = gw; it < NITEMS; it += NGW) {
        int r = it;
        if (r < 2 * (2 * I_G + I_D)) {
            const int f = r >= (2 * I_G + I_D) ? 1 : 0; r -= f * (2 * I_G + I_D);
            if ((which == 1 && f == 1) || (which == 2 && f == 0)) continue;
            bf16_t* WGU = (bf16_t*)(ws + (f ? WS_WGU2 : WS_WGU1)); bf16_t* WD = (bf16_t*)(ws + (f ? WS_WD2 : WS_WD1));
            const float* wg = p.in[f ? 26 : 3]; const float* wu = p.in[f ? 27 : 4]; const float* wd = p.in[f ? 28 : 5];
            if (r < 2 * I_G) { const bool up = r >= I_G; const int q = up ? r - I_G : r; const int kb = q / 88, nb = q % 88, n0 = nb * 32;
                transpose_item(up ? wu : wg, DFF, kb * 64, n0, WGU, DM, 0, (n0 >> 7) * 256 + (n0 & 127) + (up ? 128 : 0), false, scr, lane); }
            else { r -= 2 * I_G; const int kb = r / 32, nb = r % 32; transpose_item(wd, DM, kb * 64, nb * 32, WD, DFF, 0, nb * 32, false, scr, lane); }
            continue;
        }
        r -= 2 * (2 * I_G + I_D);
        { const bool is_out = (r >= I_IN + I_UQ + I_UKV) && (r < I_IN + I_UQ + I_UKV + I_OUT); if ((which == 1 && is_out) || (which == 2 && !is_out)) continue; }
        if (r < I_IN) { const int kb = r / 81, nb = r % 81, n0 = nb * 32; const int dr = n0 < 672 ? n0 : (n0 < 2208 ? 768 + (n0 - 672) : 2304 + (n0 - 2208));
            transpose_item(p.in[7], 2592, kb * 64, n0, (bf16_t*)(ws + WS_WIN), DM, 0, dr, false, scr, lane); continue; }
        r -= I_IN;
        if (r < I_UQ) { const int kb = r / 24, nb = r % 24; transpose_item(p.in[9], 768, kb * 64, nb * 32, (bf16_t*)(ws + WS_WUQ), 384, 0, nb * 32, (nb % 3) == 2, scr, lane, 0.10206207261596575f * 1.4426950408889634f); continue; }
        r -= I_UQ;
        if (r < I_UKV) { const int kb = r / 32, nb = r % 32, h = nb >> 2, part = nb & 3; const int dr = part < 2 ? h * 64 + part * 32 : 512 + h * 64 + (part - 2) * 32;
            transpose_item(p.in[11], 1024, kb * 64, nb * 32, (bf16_t*)(ws + WS_WUKV), 256, 0, dr, false, scr, lane); continue; }
        r -= I_UKV;
        if (r < I_OUT) { const int kb = r / 32, nb = r % 32; transpose_item(p.in[24], DM, kb * 64, nb * 32, (bf16_t*)(ws + WS_WOUT), DM, 0, nb * 32, false, scr, lane); continue; }
        r -= I_OUT;
        bf16_t* WL = (bf16_t*)(ws + WS_WL);
        if (r < 4 * I_L) { const int which = r / I_L, nb = r % I_L, d = which & 1; const bool isa = which >= 2;
            transpose_item(p.in[isa ? 17 : 15] + (size_t)d * 64 * 512, 512, 0, nb * 32, WL + (isa ? 131072 : 0), 128, d * 64, d * 512 + nb * 32, false, scr, lane); continue; }
        r -= 4 * I_L;
        { const int kb = r / 16, nb = r % 16; transpose_item(p.in[18], 512, kb * 64, nb * 32, WL + 262144, 128, 0, nb * 32, false, scr, lane); }
    }
    if (which == 2) return;
    { bf16_t* WIN = (bf16_t*)(ws + WS_WIN); const u32x4 z = {0u, 0u, 0u, 0u};
      for (int i = gtid; i < 224 * 128; i += GT) { const int rr = i >> 7, c = i & 127; const int row = rr < 96 ? 672 + rr : 2688 + (rr - 96); *(u32x4*)(WIN + (size_t)row * DM + c * 8) = z; } }
    { float* rope = (float*)(ws + WS_ROPE);
      for (int i = gtid; i < 16384 * 16; i += GT) { const int t = i >> 4, k = i & 15; const float ang = (float)t * ROPE_INV[k];
        const double a = (double)ang; const double n = rint(a * 0.15915494309189535); const double rr = a - n * 6.283185307179586; const float rf = (float)rr;
        rope[2 * i] = cosf(rf); rope[2 * i + 1] = sinf(rf); } }
}

__device__ __forceinline__ void norm_row(const float* src, const bf16_t* add, const float* gain, bf16_t* ob, float* of, int lane) {
    f32x4 v[4]; float s = 0.f;
#pragma unroll
    for (int j = 0; j < 4; ++j) { v[j] = *((const f32x4*)src + lane + 64 * j);
        if (add) { const u32x2 d = *((const u32x2*)add + lane + 64 * j); v[j][0] += bflo(d.x); v[j][1] += bfhi(d.x); v[j][2] += bflo(d.y); v[j][3] += bfhi(d.y); }
        s += (v[j][0] * v[j][0] + v[j][1] * v[j][1]) + (v[j][2] * v[j][2] + v[j][3] * v[j][3]); }
    const float rstd = 1.0f / sqrtf(wave_sum(s) * (1.f / DM) + NORM_EPS);
#pragma unroll
    for (int j = 0; j < 4; ++j) { const f32x4 g = *((const f32x4*)gain + lane + 64 * j); const f32x4 o = v[j] * rstd * g;
        if (ob) { u32x2 w; w.x = pkbf(o[0], o[1]); w.y = pkbf(o[2], o[3]); *((u32x2*)ob + lane + 64 * j) = w; }
        else *((f32x4*)of + lane + 64 * j) = o; }
}

__device__ __forceinline__ void norm_row_bf(const bf16_t* src, const float* gain, bf16_t* ob, float* of, int lane) {
    float v[16]; float s = 0.f;
    const u32x4 w0 = *((const u32x4*)src + lane), w1 = *((const u32x4*)src + lane + 64);
    unpack8bf(w0, v); unpack8bf(w1, v + 8);
#pragma unroll
    for (int e = 0; e < 16; ++e) s += v[e] * v[e];
    const float rstd = 1.0f / sqrtf(wave_sum(s) * (1.f / DM) + NORM_EPS);
#pragma unroll
    for (int h = 0; h < 2; ++h) { const float* g = gain + h * 512 + lane * 8; const f32x4 g0 = *(const f32x4*)g, g1 = *(const f32x4*)(g + 4);
        float o[8];
#pragma unroll
        for (int e = 0; e < 4; ++e) { o[e] = v[h * 8 + e] * rstd * g0[e]; o[4 + e] = v[h * 8 + 4 + e] * rstd * g1[e]; }
        if (ob) { u32x4 w; w.x = pkbf(o[0], o[1]); w.y = pkbf(o[2], o[3]); w.z = pkbf(o[4], o[5]); w.w = pkbf(o[6], o[7]); *((u32x4*)ob + lane + 64 * h) = w; }
        else { const f32x4 a = {o[0], o[1], o[2], o[3]}, b = {o[4], o[5], o[6], o[7]}; *(f32x4*)(of + h * 512 + lane * 8) = a; *(f32x4*)(of + h * 512 + lane * 8 + 4) = b; } }
}

__device__ __forceinline__ void p5_row(const P& p, int row, int lane) {
    unsigned char* ws = p.ws;
    bf16_t* za = (bf16_t*)(ws + WS_ZA) + (size_t)row * 768;
    { unsigned* q = (unsigned*)(za + lane * 6); const unsigned w0 = q[0], w1 = q[1], w2 = q[2];
      float f[6] = {bflo(w0), bfhi(w0), bflo(w1), bfhi(w1), bflo(w2), bfhi(w2)}; float s = 0.f;
#pragma unroll
      for (int e = 0; e < 6; ++e) s += f[e] * f[e];
      const float rstd = 1.0f / sqrtf(wave_sum(s) * (1.f / 384.f) + NORM_EPS); const float* g = p.in[8] + lane * 6;
#pragma unroll
      for (int e = 0; e < 6; ++e) f[e] = f[e] * rstd * g[e];
      q[0] = pkbf(f[0], f[1]); q[1] = pkbf(f[2], f[3]); q[2] = pkbf(f[4], f[5]); }
    { unsigned* q = (unsigned*)(za + 384 + lane * 4); const unsigned w0 = q[0], w1 = q[1];
      float f[4] = {bflo(w0), bfhi(w0), bflo(w1), bfhi(w1)}; float s = 0.f;
#pragma unroll
      for (int e = 0; e < 4; ++e) s += f[e] * f[e];
      const float rstd = 1.0f / sqrtf(wave_sum(s) * (1.f / 256.f) + NORM_EPS); const float* g = p.in[10] + lane * 4;
#pragma unroll
      for (int e = 0; e < 4; ++e) f[e] = f[e] * rstd * g[e];
      q[0] = pkbf(f[0], f[1]); q[1] = pkbf(f[2], f[3]); }
    if (lane < 16) { const float x1 = __uint_as_float((unsigned)za[640 + lane] << 16), x2 = __uint_as_float((unsigned)za[656 + lane] << 16);
      const float* rp = (const float*)(ws + WS_ROPE) + ((size_t)seq_pos(row) * 16 + lane) * 2; const float c = rp[0], s = rp[1];
      const unsigned w = pkbf(x1 * c - x2 * s, x1 * s + x2 * c);
      unsigned* kr = (unsigned*)((bf16_t*)((unsigned char*)p.out + DO_K) + (size_t)row * 768 + 64) + lane;
#pragma unroll
      for (int h = 0; h < NH; ++h) kr[h * 48] = w; }
    { const int pos = seq_pos(row), L = row < TP ? 8192 : 16384;
      const bf16_t* zl = (const bf16_t*)(ws + WS_ZL) + (size_t)row * 512 + lane * 6;
      const unsigned* q = (const unsigned*)zl; const unsigned w0 = q[0], w1 = q[1], w2 = q[2];
      unsigned p0 = 0, p1 = 0, p2 = 0, n0 = 0, n1 = 0, n2 = 0;
      if (pos > 0) { const unsigned* qq = (const unsigned*)(zl - 512); p0 = qq[0]; p1 = qq[1]; p2 = qq[2]; }
      if (pos < L - 1) { const unsigned* qq = (const unsigned*)(zl + 512); n0 = qq[0]; n1 = qq[1]; n2 = qq[2]; }
      const float z[6] = {bflo(w0), bfhi(w0), bflo(w1), bfhi(w1), bflo(w2), bfhi(w2)};
      const float zp[6] = {bflo(p0), bfhi(p0), bflo(p1), bfhi(p1), bflo(p2), bfhi(p2)};
      const float zn[6] = {bflo(n0), bfhi(n0), bflo(n1), bfhi(n1), bflo(n2), bfhi(n2)};
      const float* mu0 = p.in[13] + 1536 + lane * 6; const float* mu1 = p.in[13] + 1920 + 1536 + lane * 6;
      float o[6];
#pragma unroll
      for (int e = 0; e < 6; ++e) { const int c = lane * 6 + e; const float zs = z[e] + mu0[e] * (zp[e] - z[e]) + mu1[e] * (zn[e] - z[e]);
        float r;
        if (c < 128) { const float t = __expf(2.f * zs); r = 1.f - 2.f * __builtin_amdgcn_rcpf(t + 1.f); }
        else if (c < 256) r = zs;
        else r = fsigmoid(zs);
        o[e] = r; }
      unsigned* lo = (unsigned*)((bf16_t*)(ws + WS_LIN) + (size_t)row * 384 + lane * 6);
      lo[0] = pkbf(o[0], o[1]); lo[1] = pkbf(o[2], o[3]); lo[2] = pkbf(o[4], o[5]); }
}

__device__ __forceinline__ void shift8(const bf16_t* base, int pitch, bool hasp, bool hasn, const float* mu0, const float* mu1, float* o) {
    const u32x4 w = *(const u32x4*)base; u32x4 wp = {0u, 0u, 0u, 0u}, wn = {0u, 0u, 0u, 0u};
    if (hasp) wp = *(const u32x4*)(base - pitch);
    if (hasn) wn = *(const u32x4*)(base + pitch);
    float z[8], zp[8], zn[8]; unpack8bf(w, z); unpack8bf(wp, zp); unpack8bf(wn, zn);
#pragma unroll
    for (int e = 0; e < 8; ++e) o[e] = z[e] + mu0[e] * (zp[e] - z[e]) + mu1[e] * (zn[e] - z[e]);
}
__device__ __forceinline__ float sum8(float v) { v += __shfl_xor(v, 1); v += __shfl_xor(v, 2); v += __shfl_xor(v, 4); return v; }
__device__ __forceinline__ void p10_att_row(const P& p, int row, int lane) {
    unsigned char* ws = p.ws;
    bf16_t* mix = (bf16_t*)(ws + WS_MIX) + (size_t)row * 1024;
    { u32x4* q = (u32x4*)(mix + lane * 8); const u32x4 w = *q; float f[8]; unpack8bf(w, f); float s = 0.f;
#pragma unroll
      for (int e = 0; e < 8; ++e) s += f[e] * f[e];
      const float rstd = 1.0f / sqrtf(wave_sum(s) * (1.f / 512.f) + NORM_EPS); const float* g = p.in[12] + lane * 8;
#pragma unroll
      for (int e = 0; e < 8; ++e) f[e] = f[e] * rstd * g[e];
      u32x4 o; o.x = pkbf(f[0], f[1]); o.y = pkbf(f[2], f[3]); o.z = pkbf(f[4], f[5]); o.w = pkbf(f[6], f[7]); *q = o; }
}
__device__ __forceinline__ void p10_row(const P& p, int row, int lane) {
    unsigned char* ws = p.ws;
    bf16_t* mix = (bf16_t*)(ws + WS_MIX) + (size_t)row * 1024;
    { const int c = lane * 8; const int pos = seq_pos(row), L = row < TP ? 8192 : 16384; const bool hasp = pos > 0, hasn = pos < L - 1;
      const float* mu = p.in[13];
      const bf16_t* zr = (const bf16_t*)(ws + WS_ZRKV) + (size_t)row * 1536 + c;
      float v[8];
      shift8(zr + 1024, 1536, hasp, hasn, mu + 1024 + c, mu + 1920 + 1024 + c, v);
      float g[8]; unpack8bf(*(const u32x4*)(mix + 512 + c), g);
      const bf16_t* yp = (const bf16_t*)(ws + WS_Y) + (size_t)row * 512 + c;
      float y[8], yb2[8]; unpack8bf(*(const u32x4*)yp, y); unpack8bf(*(const u32x4*)(yp + (size_t)T * 512), yb2);
#pragma unroll
      for (int e = 0; e < 8; ++e) y[e] += yb2[e];
      float s = 0.f;
#pragma unroll
      for (int e = 0; e < 8; ++e) s += y[e];
      const float mean = sum8(s) * (1.f / 64.f); float q = 0.f;
#pragma unroll
      for (int e = 0; e < 8; ++e) { y[e] -= mean; q += y[e] * y[e]; }
      const float rstd = 1.0f / sqrtf(sum8(q) * (1.f / 64.f) + LNX_EPS);
      const float* lw = p.in[22] + c; const float* lb = p.in[23] + c;
      const float* bsp = (const float*)(ws + WS_BS) + (size_t)row * 8 + (lane >> 3);
      const float bs = bsp[0] + bsp[(size_t)T * 8];
      float o[8];
#pragma unroll
      for (int e = 0; e < 8; ++e) o[e] = (y[e] * rstd * lw[e] + lb[e] + bs * v[e]) * g[e];
      u32x4 w; w.x = pkbf(o[0], o[1]); w.y = pkbf(o[2], o[3]); w.z = pkbf(o[4], o[5]); w.w = pkbf(o[6], o[7]);
      *(u32x4*)(mix + 512 + c) = w; }
}

namespace att {
using bf16x8 = __attribute__((ext_vector_type(8))) short;
using s16x4  = __attribute__((ext_vector_type(4))) short;
using f32x16 = __attribute__((ext_vector_type(16))) float;
constexpr int NW = 8, QBLK = 32, KVBLK = 64, LDQ = 768, LDK = 768, LDV = 512, LDO = 1024;
constexpr float SCALE = 0.10206207261596575f, THR = 8.f;
constexpr int SHM_V = 16384, SHM_K = 16384, NBUF = 3, SHM_ATTN = NBUF * SHM_V + NBUF * SHM_K + NW * 64 * 4;
#define KSWZ(row, colB) ((row) * 256 + ((colB) ^ (((row) & 7) << 4)))
#define SBAR() __builtin_amdgcn_sched_barrier(0)
__device__ __forceinline__ int crow(int r, int hi) { return (r & 3) + 8 * (r >> 2) + 4 * hi; }
__device__ __forceinline__ unsigned cvtpk(float lo, float hi) { unsigned r; asm volatile("v_cvt_pk_bf16_f32 %0, %1, %2" : "=v"(r) : "v"(lo), "v"(hi)); return r; }
constexpr float THRL = 11.5415603f;
template <bool FIRST>
__device__ __forceinline__ void partialSM(f32x16& p0, f32x16& p1, float& m_reg, float& alpha) {
  float a = fmaxf(fmaxf(p0[0], p0[1]), p0[2]), b = fmaxf(fmaxf(p1[0], p1[1]), p1[2]);
#pragma unroll
  for (int r = 3; r < 15; r += 2) { a = fmaxf(fmaxf(a, p0[r]), p0[r + 1]); b = fmaxf(fmaxf(b, p1[r]), p1[r + 1]); }
  float pmax = fmaxf(fmaxf(a, b), fmaxf(p0[15], p1[15]));
  { auto rr = __builtin_amdgcn_permlane32_swap(__float_as_uint(pmax), __float_as_uint(pmax), false, false);
    pmax = fmaxf(__uint_as_float(rr[0]), __uint_as_float(rr[1])); }
  alpha = 1.f;
  if (FIRST || !__builtin_expect(__all(pmax <= THRL), 1)) {
    const float dl = FIRST ? pmax : fmaxf(pmax, 0.f);
    m_reg += dl; if (!FIRST) alpha = __builtin_amdgcn_exp2f(-dl);
#pragma unroll
    for (int r = 0; r < 16; ++r) { p0[r] -= dl; p1[r] -= dl; }
  }
#pragma unroll
  for (int r = 0; r < 16; ++r) p0[r] = __builtin_amdgcn_exp2f(p0[r]);
}
__device__ __forceinline__ void finishSM(f32x16& p0, f32x16& p1, float alpha, float& l_reg, bf16x8& pa0, bf16x8& pa1, bf16x8& pa2, bf16x8& pa3) {
#pragma unroll
  for (int r = 0; r < 16; ++r) p1[r] = __builtin_amdgcn_exp2f(p1[r]);
  typedef float f2_t __attribute__((ext_vector_type(2)));
  f2_t s2a = {p0[0], p0[1]}, s2b = {p1[0], p1[1]};
#pragma unroll
  for (int r = 2; r < 16; r += 2) { s2a += (f2_t){p0[r], p0[r + 1]}; s2b += (f2_t){p1[r], p1[r + 1]}; }
  s2a += s2b; float ps = s2a.x + s2a.y;
  { auto rr = __builtin_amdgcn_permlane32_swap(__float_as_uint(ps), __float_as_uint(ps), false, false);
    ps = __uint_as_float(rr[0]) + __uint_as_float(rr[1]); }
  l_reg = l_reg * alpha + ps;
#define PK4(PP, BASE, OUT) do { unsigned a0 = cvtpk(PP[BASE + 0], PP[BASE + 1]), a1 = cvtpk(PP[BASE + 2], PP[BASE + 3]);   \
    unsigned b0 = cvtpk(PP[BASE + 4], PP[BASE + 5]), b1 = cvtpk(PP[BASE + 6], PP[BASE + 7]);                              \
    auto r0 = __builtin_amdgcn_permlane32_swap(a0, b0, false, false); auto r1 = __builtin_amdgcn_permlane32_swap(a1, b1, false, false); \
    u32x4 w = {r0[0], r1[0], r0[1], r1[1]}; OUT = *reinterpret_cast<bf16x8*>(&w); } while (0)
  PK4(p0, 0, pa0); PK4(p0, 8, pa1); PK4(p1, 0, pa2); PK4(p1, 8, pa3);
#undef PK4
}
__device__ __forceinline__ void qkt(f32x16& p0, f32x16& p1, const char* Ks, const bf16x8* qr, int r32, int hi, float m_reg) {
#pragma unroll
  for (int r = 0; r < 16; ++r) { p0[r] = -m_reg; p1[r] = -m_reg; }
#pragma unroll
  for (int d0 = 0; d0 < 6; ++d0) { int cb = (d0 * 16 + hi * 8) * 2;
    bf16x8 b0 = *reinterpret_cast<const bf16x8*>(Ks + KSWZ(r32, cb));
    bf16x8 b1 = *reinterpret_cast<const bf16x8*>(Ks + KSWZ(32 + r32, cb));
    p0 = __builtin_amdgcn_mfma_f32_32x32x16_bf16(b0, qr[d0], p0, 0, 0, 0);
    p1 = __builtin_amdgcn_mfma_f32_32x32x16_bf16(b1, qr[d0], p1, 0, 0, 0); }
}
__device__ __forceinline__ int v_st(int k, int c) { const int kk = (k & ~0xC) | ((k & 4) << 1) | ((k & 8) >> 1); return ((kk >> 3) * 4 + (c >> 5)) * 512 + ((kk & 7) * 32 + (c & 31)) * 2; }
__device__ __forceinline__ int v_rd_base(int lane) { return ((lane & 3) << 3) | (((lane >> 2) & 3) << 6) | (((lane >> 4) & 1) << 5) | (((lane >> 5) & 1) << 8); }
constexpr int v_rd_off(int d0, int ks, int half) { return d0 * 512 + ks * 4096 + half * 2048; }
template <int OFF> __device__ __forceinline__ s16x4 tr_read(int vb) {
  s16x4 r; asm volatile("ds_read_b64_tr_b16 %0, %1 offset:%2" : "=&v"(r) : "v"(vb), "i"(OFF) : "memory"); return r;
}
template <int D0> __device__ __forceinline__ void pv_one(f32x16& od, int vb, bf16x8 pa0, bf16x8 pa1, bf16x8 pa2, bf16x8 pa3) {
  const s16x4 l0 = tr_read<v_rd_off(D0, 0, 0)>(vb), h0 = tr_read<v_rd_off(D0, 0, 1)>(vb), l1 = tr_read<v_rd_off(D0, 1, 0)>(vb), h1 = tr_read<v_rd_off(D0, 1, 1)>(vb);
  const s16x4 l2 = tr_read<v_rd_off(D0, 2, 0)>(vb), h2 = tr_read<v_rd_off(D0, 2, 1)>(vb), l3 = tr_read<v_rd_off(D0, 3, 0)>(vb), h3 = tr_read<v_rd_off(D0, 3, 1)>(vb);
  asm volatile("s_waitcnt lgkmcnt(0)" ::: "memory"); SBAR();
#define PKV(L, H) (bf16x8){L[0], L[1], L[2], L[3], H[0], H[1], H[2], H[3]}
  od = __builtin_amdgcn_mfma_f32_32x32x16_bf16(pa0, PKV(l0, h0), od, 0, 0, 0);
  od = __builtin_amdgcn_mfma_f32_32x32x16_bf16(pa1, PKV(l1, h1), od, 0, 0, 0);
  od = __builtin_amdgcn_mfma_f32_32x32x16_bf16(pa2, PKV(l2, h2), od, 0, 0, 0);
  od = __builtin_amdgcn_mfma_f32_32x32x16_bf16(pa3, PKV(l3, h3), od, 0, 0, 0);
#undef PKV
}
__device__ __forceinline__ void pv_d0(f32x16* o, int vb, bf16x8 pa0, bf16x8 pa1, bf16x8 pa2, bf16x8 pa3) {
  pv_one<0>(o[0], vb, pa0, pa1, pa2, pa3); pv_one<1>(o[1], vb, pa0, pa1, pa2, pa3);
}
__device__ __forceinline__ void attn_unit(const bf16_t* __restrict__ Qb, const bf16_t* __restrict__ Kh, const bf16_t* __restrict__ Vh, bf16_t* __restrict__ Ob, int seq, char* lds, const float* rope, int qpos0) {
  int tid_ = threadIdx.x; asm volatile("" : "+v"(tid_));
  const int tid = tid_, wid = tid >> 6, lane = tid & 63, r32 = lane & 31, hi = lane >> 5;
  char* V_lds = lds; char* K_lds = lds + NBUF * SHM_V;
  float* ws = (float*)(lds + NBUF * SHM_V + NBUF * SHM_K) + wid * 64; float* li_l = ws; float* al_l = ws + 32;
  float m_reg = 0.f, l_reg = 0; f32x16 o[2] = {}; bf16x8 qr[6];
  const bf16_t* Qw = Qb + (long)(wid * QBLK + r32) * LDQ + hi * 8;
#pragma unroll
  for (int d0 = 0; d0 < 6; ++d0) qr[d0] = *reinterpret_cast<const bf16x8*>(Qw + d0 * 16);
#pragma unroll
  for (int d0 = 4; d0 < 6; ++d0) {
    const float* rp = rope + ((size_t)(qpos0 + wid * QBLK + r32) * 16 + (d0 - 4) * 8 + hi * 4) * 2;
    const f32x4 t0 = *(const f32x4*)rp, t1 = *(const f32x4*)(rp + 4);
    float f[8]; unpack8bf(*reinterpret_cast<const u32x4*>(&qr[d0]), f);
    u32x4 w;
    w.x = cvtpk(f[0] * t0[0] - f[1] * t0[1], f[0] * t0[1] + f[1] * t0[0]);
    w.y = cvtpk(f[2] * t0[2] - f[3] * t0[3], f[2] * t0[3] + f[3] * t0[2]);
    w.z = cvtpk(f[4] * t1[0] - f[5] * t1[1], f[4] * t1[1] + f[5] * t1[0]);
    w.w = cvtpk(f[6] * t1[2] - f[7] * t1[3], f[6] * t1[3] + f[7] * t1[2]);
    qr[d0] = *reinterpret_cast<bf16x8*>(&w);
  }
  const int kr0 = tid / 12, kc0 = (tid % 12) * 8, kr1 = (512 + tid) / 12, kc1 = ((512 + tid) % 12) * 8; const bool k2 = __builtin_amdgcn_readfirstlane(tid) < 256;
  const int vr = tid >> 3, vc = (tid & 7) * 8, vst = v_st(vr, vc);
  const int kst0 = KSWZ(kr0, kc0 * 2), kst1 = KSWZ(kr1, kc1 * 2);
  const int vb0 = (int)(uintptr_t)V_lds + v_rd_base(lane);
  struct { bf16x8 vs, ks0, ks1; } sr_;
  const unsigned vo_ = (unsigned)(vr * LDV + vc) * 2u, ko0_ = (unsigned)(kr0 * LDK + kc0) * 2u, ko1_ = (unsigned)(kr1 * LDK + kc1) * 2u;
#define SLOAD(k0) do { const unsigned kt_ = (unsigned)(k0) * (LDK * 2u), vt_ = (unsigned)(k0) * (LDV * 2u); \
    sr_.vs = *reinterpret_cast<const bf16x8*>((const char*)Vh + (vo_ + vt_)); \
    sr_.ks0 = *reinterpret_cast<const bf16x8*>((const char*)Kh + (ko0_ + kt_)); \
    if (k2) sr_.ks1 = *reinterpret_cast<const bf16x8*>((const char*)Kh + (ko1_ + kt_)); } while (0)
#define SWRITE(bo) do { *(bf16x8*)(V_lds + (bo) + vst) = sr_.vs; *(bf16x8*)(K_lds + (bo) + kst0) = sr_.ks0; \
    if (k2) *(bf16x8*)(K_lds + (bo) + kst1) = sr_.ks1; } while (0)
#define RESC(a) do { if (__any((a) < 1.f)) { if (hi == 0) al_l[r32] = (a); asm volatile("s_waitcnt lgkmcnt(0)" ::: "memory"); \
    _Pragma("unroll") for (int d = 0; d < 2; ++d) _Pragma("unroll") for (int r = 0; r < 16; ++r) o[d][r] *= al_l[crow(r, hi)]; } } while (0)
#define ROT3() do { const int t_ = bp; bp = bc; bc = bn; bn = t_; } while (0)
  static_assert(SHM_V == SHM_K, "one ring offset serves both");
  f32x16 pA0, pA1, pB0, pB1; float alA, alB; bf16x8 pa0, pa1, pa2, pa3; const int NT = seq / KVBLK;
  int bp = 0, bc = SHM_K, bn = 2 * SHM_K;
  if (__builtin_amdgcn_readfirstlane(tid) >= 256) __builtin_amdgcn_s_setprio(1);
  SLOAD(0); SWRITE(0); SLOAD(KVBLK); __syncthreads();
  qkt(pA0, pA1, K_lds, qr, r32, hi, m_reg); partialSM<true>(pA0, pA1, m_reg, alA);
  SWRITE(SHM_K); SLOAD(2 * KVBLK); __syncthreads();
  for (int j = 1; j + 1 < NT; j += 2) {
    SBAR(); qkt(pB0, pB1, K_lds + bc, qr, r32, hi, m_reg);
    finishSM(pA0, pA1, alA, l_reg, pa0, pa1, pa2, pa3); SBAR();
    pv_d0(o, vb0 + bp, pa0, pa1, pa2, pa3); partialSM<false>(pB0, pB1, m_reg, alB);
    SWRITE(bn); SLOAD((j + 2) * KVBLK);
    RESC(alB); __syncthreads(); ROT3();
    SBAR(); qkt(pA0, pA1, K_lds + bc, qr, r32, hi, m_reg);
    finishSM(pB0, pB1, alB, l_reg, pa0, pa1, pa2, pa3); SBAR();
    pv_d0(o, vb0 + bp, pa0, pa1, pa2, pa3); partialSM<false>(pA0, pA1, m_reg, alA);
    SWRITE(bn); if (j + 3 < NT) SLOAD((j + 3) * KVBLK);
    RESC(alA); __syncthreads(); ROT3();
  }
  SBAR(); qkt(pB0, pB1, K_lds + bc, qr, r32, hi, m_reg);
  finishSM(pA0, pA1, alA, l_reg, pa0, pa1, pa2, pa3); SBAR();
  pv_d0(o, vb0 + bp, pa0, pa1, pa2, pa3); partialSM<false>(pB0, pB1, m_reg, alB);
  RESC(alB);
  finishSM(pB0, pB1, alB, l_reg, pa0, pa1, pa2, pa3); SBAR();
  pv_d0(o, vb0 + bc, pa0, pa1, pa2, pa3);
#undef ROT3
  if (hi == 0) li_l[r32] = l_reg; asm volatile("s_waitcnt lgkmcnt(0)" ::: "memory");
  float rli[16];
#pragma unroll
  for (int r = 0; r < 16; ++r) rli[r] = __builtin_amdgcn_rcpf(li_l[crow(r, hi)]);
  bf16_t* Ow = Ob + (long)(wid * QBLK) * LDO;
#pragma unroll
  for (int r = 0; r < 16; ++r) { int orow = crow(r, hi);
#pragma unroll
    for (int d0 = 0; d0 < 2; ++d0) { const float val = o[d0][r] * rli[r]; Ow[(long)orow * LDO + d0 * 32 + r32] = (bf16_t)(cvtpk(val, val) & 0xffffu); } }
  __builtin_amdgcn_s_setprio(0);
  __syncthreads();
#undef SLOAD
#undef SWRITE
#undef RESC
}
#undef KSWZ
#undef SBAR
}

typedef float f32x2 __attribute__((ext_vector_type(2)));
template <int CTRL> __device__ __forceinline__ float dppx(float v) { return __int_as_float(__builtin_amdgcn_update_dpp(0, __float_as_int(v), CTRL, 0xF, 0xF, true)); }
__device__ __forceinline__ float reduce16(float v) { v += dppx<0xB1>(v); v += dppx<0x4E>(v); v += dppx<0x141>(v); v += dppx<0x140>(v); return v; }
struct ScanRaw { u32x4 r[3], k[3], v[3], w, a; };
__device__ __forceinline__ void scan_load(ScanRaw& R, const bf16_t* zr, const unsigned short* wa, bool hasp, bool hasn) {
    const u32x4 z = {0u, 0u, 0u, 0u};
    R.r[1] = *(const u32x4*)zr; R.k[1] = *(const u32x4*)(zr + 512); R.v[1] = *(const u32x4*)(zr + 1024);
    R.r[0] = z; R.k[0] = z; R.v[0] = z; R.r[2] = z; R.k[2] = z; R.v[2] = z;
    if (hasp) { R.r[0] = *(const u32x4*)(zr - 1536); R.k[0] = *(const u32x4*)(zr - 1536 + 512); R.v[0] = *(const u32x4*)(zr - 1536 + 1024); }
    if (hasn) { R.r[2] = *(const u32x4*)(zr + 1536); R.k[2] = *(const u32x4*)(zr + 1536 + 512); R.v[2] = *(const u32x4*)(zr + 1536 + 1024); }
    R.w = *(const u32x4*)wa; R.a = *(const u32x4*)(wa + 1024);
}
__device__ __forceinline__ void shift8r(const u32x4 wp, const u32x4 w, const u32x4 wn, const float* mu0, const float* mu1, float* o) {
    float z[8], zp[8], zn[8]; unpack8bf(w, z); unpack8bf(wp, zp); unpack8bf(wn, zn);
#pragma unroll
    for (int e = 0; e < 8; ++e) o[e] = z[e] + mu0[e] * (zp[e] - z[e]) + mu1[e] * (zn[e] - z[e]);
}
template <int RPL, int NSW>
__device__ __forceinline__ void scan_item(const P& p, LAS unsigned char* lds, int seqbase, int L, int head, int dir, int part, int step0, int nsteps, int mode, float* qc, float* smid) {
    constexpr int WR = NSW * 4 * RPL, TC = 32, ARR = TC * 64;
    constexpr int BUF_FLOATS = 5 * ARR + 5 * TC * WR;
    static_assert(WR == 32, "flush mapping assumes 32 rows per workgroup");
    static_assert(2 * BUF_FLOATS * 4 <= 131072, "scan LDS");
    LAS float* lf = (LAS float*)lds;
    int tid_ = threadIdx.x; asm volatile("" : "+v"(tid_));
    const int tid = tid_, wave = __builtin_amdgcn_readfirstlane(tid >> 6), lane = tid & 63;
    const int rowbase = part * WR, NC = nsteps / TC;
    unsigned char* ws = p.ws;
    const bf16_t* ZR = (const bf16_t*)(ws + WS_ZRKV);
    const unsigned short* WA = (const unsigned short*)((unsigned char*)p.out + DO_WA);
    bf16_t* Yd = (bf16_t*)(ws + WS_Y) + (dir ? (size_t)T * 512 : 0);
    const bool is_scan = wave < NSW;
    const bool is_prod = (NSW == 4) ? (wave >= 4) : ((wave & 2) != 0);
    if (is_prod) {
        const int pw = (NSW == 4) ? (wave - 4) : (((wave >> 2) << 1) | (wave & 1));
        const int ptid = pw * 64 + lane, s = ptid >> 3, d0 = (ptid & 7) * 8, c = head * 64 + d0;
        float mu[6][8], kk_k[8], k_a[8], r_kk[8];
#pragma unroll
        for (int e = 0; e < 8; ++e) { mu[0][e] = p.in[13][c + e]; mu[1][e] = p.in[13][1920 + c + e]; mu[2][e] = p.in[13][512 + c + e]; mu[3][e] = p.in[13][1920 + 512 + c + e];
            mu[4][e] = p.in[13][1024 + c + e]; mu[5][e] = p.in[13][1920 + 1024 + c + e]; kk_k[e] = p.in[19][c + e]; k_a[e] = p.in[20][c + e]; r_kk[e] = p.in[21][c + e]; }
        float* BSd = (float*)(ws + WS_BS) + (size_t)dir * T * 8;
#define SCAN_FLUSH() do { const int r0_ = (ptid & 7) * 4; float o_[4]; \
            _Pragma("unroll") for (int i_ = 0; i_ < 4; ++i_) { const f32x4 pv_ = *(LAS const f32x4*)(yb + (s * WR + r0_ + i_) * 4); o_[i_] = (pv_[0] + pv_[1]) + (pv_[2] + pv_[3]); } \
            if (mode == 0) { u32x2 w_; w_.x = pkbf(o_[0], o_[1]); w_.y = pkbf(o_[2], o_[3]); *(u32x2*)(Yd + (size_t)(seqbase + t) * 512 + head * 64 + rowbase + r0_) = w_; } \
            else { const f32x4 q_ = {o_[0], o_[1], o_[2], o_[3]}; *(f32x4*)(qc + (size_t)(step - step0) * 64 + rowbase + r0_) = q_; } } while (0)
        ScanRaw cur, nxt;
        { const int t = dir ? (L - 1 - (step0 + s)) : (step0 + s); scan_load(cur, ZR + (size_t)(seqbase + t) * 1536 + c, WA + (size_t)(seqbase + t) * 2048 + dir * 512 + c, t > 0, t < L - 1); }
        nxt = cur;
        for (int ch = 0; ch <= NC; ++ch) {
            if (ch + 1 < NC) { const int step = step0 + (ch + 1) * TC + s; const int t = dir ? (L - 1 - step) : step;
                scan_load(nxt, ZR + (size_t)(seqbase + t) * 1536 + c, WA + (size_t)(seqbase + t) * 2048 + dir * 512 + c, t > 0, t < L - 1); }
            if (ch >= 2) { const int fc = ch - 2; LAS const float* yb = lf + (fc & 1) * BUF_FLOATS + 5 * ARR + TC * WR;
                const int step = step0 + fc * TC + s; const int t = dir ? (L - 1 - step) : step;
                SCAN_FLUSH(); }
            if (ch < NC) {
                LAS float* b = lf + (ch & 1) * BUF_FLOATS;
                float r[8], k[8], v[8], w[8], a[8];
                shift8r(cur.r[0], cur.r[1], cur.r[2], mu[0], mu[1], r);
                shift8r(cur.k[0], cur.k[1], cur.k[2], mu[2], mu[3], k);
                shift8r(cur.v[0], cur.v[1], cur.v[2], mu[4], mu[5], v);
                unpack8h(cur.w, w); unpack8h(cur.a, a);
                float kk[8], ss = 0.f;
#pragma unroll
                for (int e = 0; e < 8; ++e) { kk[e] = k[e] * kk_k[e]; ss += kk[e] * kk[e]; }
                ss = sum8(ss);
                const float inv = 1.0f / fmaxf(sqrtf(ss), 1e-12f);
                if (mode == 0 && part == 0) {
                    float bsum = 0.f;
#pragma unroll
                    for (int e = 0; e < 8; ++e) bsum += r[e] * (k[e] * (1.f + (a[e] - 1.f) * k_a[e])) * r_kk[e];
                    bsum = sum8(bsum);
                    const int stepb = step0 + ch * TC + s; const int tb = dir ? (L - 1 - stepb) : stepb;
                    if ((ptid & 7) == 0) BSd[(size_t)(seqbase + tb) * 8 + head] = bsum;
                }
                f32x4 o0, o1;
                LAS float* dst = b + s * 64 + d0;
#pragma unroll
                for (int e = 0; e < 4; ++e) { o0[e] = w[e]; o1[e] = w[4 + e]; }
                *(LAS f32x4*)(dst) = o0; *(LAS f32x4*)(dst + 4) = o1;
#pragma unroll
                for (int e = 0; e < 4; ++e) { o0[e] = k[e] * (1.f + (a[e] - 1.f) * k_a[e]); o1[e] = k[4 + e] * (1.f + (a[4 + e] - 1.f) * k_a[4 + e]); }
                *(LAS f32x4*)(dst + ARR) = o0; *(LAS f32x4*)(dst + ARR + 4) = o1;
#pragma unroll
                for (int e = 0; e < 4; ++e) { o0[e] = kk[e] * inv; o1[e] = kk[4 + e] * inv; }
                *(LAS f32x4*)(dst + 2 * ARR) = o0; *(LAS f32x4*)(dst + 2 * ARR + 4) = o1;
#pragma unroll
                for (int e = 0; e < 4; ++e) { o0[e] = kk[e] * inv * a[e]; o1[e] = kk[4 + e] * inv * a[4 + e]; }
                *(LAS f32x4*)(dst + 3 * ARR) = o0; *(LAS f32x4*)(dst + 3 * ARR + 4) = o1;
#pragma unroll
                for (int e = 0; e < 4; ++e) { o0[e] = r[e]; o1[e] = r[4 + e]; }
                *(LAS f32x4*)(dst + 4 * ARR) = o0; *(LAS f32x4*)(dst + 4 * ARR + 4) = o1;
                if (d0 >= rowbase && d0 < rowbase + WR) {
#pragma unroll
                    for (int e = 0; e < 8; ++e) b[5 * ARR + s * WR + (d0 - rowbase) + e] = mode ? 0.f : v[e]; }
            }
            cur = nxt;
            __syncthreads();
        }
        { const int fc = NC - 1; LAS const float* yb = lf + (fc & 1) * BUF_FLOATS + 5 * ARR + TC * WR;
          const int step = step0 + fc * TC + s; const int t = dir ? (L - 1 - step) : step;
          SCAN_FLUSH(); }
#undef SCAN_FLUSH
    } else if (is_scan) {
        const int i = lane >> 4, kq = lane & 15, lr0 = wave * (4 * RPL) + i * RPL;
        LAS float* ydummy = lf + 2 * BUF_FLOATS + wave * 80 + lane;
        static_assert((2 * BUF_FLOATS + 4 * 80) * 4 <= 131072, "scan LDS incl. dummy slots");
        f32x2 S[RPL][2];
#pragma unroll
        for (int q = 0; q < RPL; ++q) { const int gk = rowbase + lr0 + q - 4 * kq;
            S[q][0] = (f32x2){(mode && gk == 0) ? 1.f : 0.f, (mode && gk == 1) ? 1.f : 0.f}; S[q][1] = (f32x2){(mode && gk == 2) ? 1.f : 0.f, (mode && gk == 3) ? 1.f : 0.f}; }
        __syncthreads();
        for (int ch = 0; ch < NC; ++ch) {
            LAS const float* b = lf + (ch & 1) * BUF_FLOATS; LAS float* yb = lf + (ch & 1) * BUF_FLOATS + 5 * ARR + TC * WR;
            f32x4 xw, xkd, xkk, xb, xr; float vrow[RPL];
#define SCAN_LD(ss) do { LAS const float* src_ = b + (ss) * 64 + kq * 4; xw = *(LAS const f32x4*)(src_); xkd = *(LAS const f32x4*)(src_ + ARR); xkk = *(LAS const f32x4*)(src_ + 2 * ARR); \
                xb = *(LAS const f32x4*)(src_ + 3 * ARR); xr = *(LAS const f32x4*)(src_ + 4 * ARR); _Pragma("unroll") for (int q = 0; q < RPL; ++q) vrow[q] = b[5 * ARR + (ss) * WR + lr0 + q]; } while (0)
            SCAN_LD(0);
#pragma unroll 4
            for (int s = 0; s < TC; ++s) {
                const f32x2 w0 = {xw[0], xw[1]}, w1 = {xw[2], xw[3]}, kd0 = {xkd[0], xkd[1]}, kd1 = {xkd[2], xkd[3]}, kk0 = {xkk[0], xkk[1]}, kk1 = {xkk[2], xkk[3]},
                            b0 = {xb[0], xb[1]}, b1 = {xb[2], xb[3]}, r0 = {xr[0], xr[1]}, r1 = {xr[2], xr[3]};
                float vr[RPL];
#pragma unroll
                for (int q = 0; q < RPL; ++q) vr[q] = vrow[q];
                { const int sn = (s + 1 < TC) ? s + 1 : s; SCAN_LD(sn); }
                float sa[RPL];
#pragma unroll
                for (int q = 0; q < RPL; ++q) { const f32x2 t = S[q][0] * kk0 + S[q][1] * kk1; sa[q] = t.x + t.y; }
                if (RPL == 2) {
                    sa[0] += dppx<0xB1>(sa[0]); sa[RPL - 1] += dppx<0xB1>(sa[RPL - 1]); sa[0] += dppx<0x4E>(sa[0]); sa[RPL - 1] += dppx<0x4E>(sa[RPL - 1]);
                    sa[0] += dppx<0x141>(sa[0]); sa[RPL - 1] += dppx<0x141>(sa[RPL - 1]); sa[0] += dppx<0x140>(sa[0]); sa[RPL - 1] += dppx<0x140>(sa[RPL - 1]);
                } else {
#pragma unroll
                    for (int q = 0; q < RPL; ++q) sa[q] = reduce16(sa[q]);
                }
                float ov[RPL];
                if (RPL == 2) {
                    const f32x2 vva = {vr[0], vr[0]}, nsa = {-sa[0], -sa[0]}, vvb = {vr[RPL - 1], vr[RPL - 1]}, nsb = {-sa[RPL - 1], -sa[RPL - 1]};
                    f32x2 a0 = nsa * b0, c0 = nsb * b0, a1 = nsa * b1, c1 = nsb * b1;
                    a0 = vva * kd0 + a0; c0 = vvb * kd0 + c0; a1 = vva * kd1 + a1; c1 = vvb * kd1 + c1;
                    S[0][0] = S[0][0] * w0 + a0; S[RPL - 1][0] = S[RPL - 1][0] * w0 + c0; S[0][1] = S[0][1] * w1 + a1; S[RPL - 1][1] = S[RPL - 1][1] * w1 + c1;
                    f32x2 ua = S[0][0] * r0, ub = S[RPL - 1][0] * r0;
                    ua = S[0][1] * r1 + ua; ub = S[RPL - 1][1] * r1 + ub;
                    ov[0] = ua.x + ua.y; ov[RPL - 1] = ub.x + ub.y;
                } else {
#pragma unroll
                for (int q = 0; q < RPL; ++q) {
                    const f32x2 vv = {vr[q], vr[q]}, ns = {-sa[q], -sa[q]};
                    S[q][0] = S[q][0] * w0 + (vv * kd0 + ns * b0);
                    S[q][1] = S[q][1] * w1 + (vv * kd1 + ns * b1);
                    const f32x2 t = S[q][0] * r0 + S[q][1] * r1; ov[q] = t.x + t.y;
                }
                }
#pragma unroll
                for (int q = 0; q < RPL; ++q) { ov[q] += dppx<0xB1>(ov[q]); ov[q] += dppx<0x4E>(ov[q]); }
                {
                    LAS float* yw = ((kq & 3) == 0) ? (yb + (s * WR + lr0) * 4 + (kq >> 2)) : ydummy;
#pragma unroll
                    for (int q = 0; q < RPL; ++q) yw[q * 4] = ov[q]; }
            }
#undef SCAN_LD
            __syncthreads();
        }
        if (smid) {
#pragma unroll
            for (int q = 0; q < RPL; ++q) { const f32x4 sv = {S[q][0].x, S[q][0].y, S[q][1].x, S[q][1].y}; *(f32x4*)(smid + (size_t)(rowbase + lr0 + q) * 64 + 4 * kq) = sv; } }
    } else {
        for (int ch = 0; ch <= NC; ++ch) __syncthreads();
    }
}

__device__ __forceinline__ void scan_fix_item(const P& p, LAS unsigned char* lds, int hd, int blk) {
    int tid_ = threadIdx.x; asm volatile("" : "+v"(tid_));
    const int tid = tid_, wave = __builtin_amdgcn_readfirstlane(tid >> 6), lane = tid & 63;
    unsigned char* ws = p.ws;
    const float* smid = (const float*)(ws + WS_SMID) + (size_t)hd * 4096;
    const float* qc = (const float*)(ws + (hd < 12 ? WS_QC0 + (size_t)hd * 2 * MiB : WS_QC1 + (size_t)(hd - 12) * 2 * MiB)) + (size_t)blk * 128 * 64;
    bf16_t* Yd = (bf16_t*)(ws + WS_Y) + ((hd & 1) ? (size_t)T * 512 : 0);
    LAS float* lq = (LAS float*)lds;
    for (int i = tid; i < 128 * 16; i += 512) *(LAS f32x4*)(lq + i * 4) = *(const f32x4*)(qc + i * 4);
    f32x4 sm[16];
#pragma unroll
    for (int i = 0; i < 16; ++i) sm[i] = *(const f32x4*)(smid + lane * 64 + i * 4);
    __syncthreads();
    const int head = hd >> 1, dir = hd & 1;
    for (int s = 0; s < 16; ++s) {
        const int j = wave * 16 + s; LAS const float* q = lq + j * 64;
        float a0 = 0.f, a1 = 0.f, a2 = 0.f, a3 = 0.f;
#pragma unroll
        for (int i = 0; i < 16; ++i) { const f32x4 qv = *(LAS const f32x4*)(q + i * 4); a0 = fmaf(sm[i][0], qv[0], a0); a1 = fmaf(sm[i][1], qv[1], a1); a2 = fmaf(sm[i][2], qv[2], a2); a3 = fmaf(sm[i][3], qv[3], a3); }
        const int jj = blk * 128 + j; const int t = dir ? (8191 - jj) : (8192 + jj);
        bf16_t* yg = Yd + (size_t)(TP + t) * 512 + head * 64 + lane;
        const float yv = __uint_as_float((unsigned)*yg << 16) + ((a0 + a1) + (a2 + a3));
        *yg = (bf16_t)(pkbf(yv, yv) & 0xffffu);
    }
    __syncthreads();
}

#define XB_TMO      128
#define XB_XCNT(j)  (256  + 64 * (j))
#define XB_XSUB(j)  (1280 + 64 * (j))
#define XB_XGEN(j)  (2304 + 64 * (j))
#define XB_TOP      3328
#define XB_TOPGEN   3392
#define XCD_BAR_WORDS 3456
#define XB_SPIN_CAP (1u << 18)

__device__ __forceinline__ unsigned xb_ld(unsigned* p)              { return __hip_atomic_load(p, __ATOMIC_RELAXED, __HIP_MEMORY_SCOPE_AGENT); }
__device__ __forceinline__ unsigned xb_add(unsigned* p, unsigned v) { return __hip_atomic_fetch_add(p, v, __ATOMIC_RELAXED, __HIP_MEMORY_SCOPE_AGENT); }
__device__ __forceinline__ unsigned xb_xcc_id() { return (unsigned)__builtin_amdgcn_s_getreg((3 << 11) | 20) & 0xFu; }
#define XB_SPIN(cond, bar) do { unsigned _sp = 0; while (cond) { __builtin_amdgcn_s_sleep(1); \
    if ((++_sp & 255u) == 0u) { if (xb_ld(&(bar)[XB_TMO])) break; if (_sp > XB_SPIN_CAP) { atomicAdd(&(bar)[XB_TMO], 1u); break; } } } } while (0)

struct XcdBarrier {
    unsigned* bar; unsigned x;
    volatile LAS unsigned* st;
};

__device__ __forceinline__ XcdBarrier xcd_barrier_post(unsigned* bar, volatile LAS unsigned* st) {
    XcdBarrier b; b.bar = bar; b.x = xb_xcc_id(); b.st = st;
    if (threadIdx.x == 0) (void)xb_add(&bar[XB_XCNT(b.x)], 1u);
    return b;
}
__device__ __forceinline__ void xcd_barrier_complete(unsigned* bar, unsigned x, unsigned& nloc, unsigned& nx) {
    const unsigned G = gridDim.x * gridDim.y * gridDim.z;
    unsigned sum, cnt, mine, sp = 0u;
    for (;;) {
        sum = 0u; cnt = 0u; mine = 0u;
#pragma unroll
        for (unsigned j = 0; j < 16; ++j) { const unsigned c = xb_ld(&bar[XB_XCNT(j)]); sum += c; cnt += (c > 0u) ? 1u : 0u; mine = (j == x) ? c : mine; }
        if (sum == G) break;
        __builtin_amdgcn_s_sleep(1);
        if ((++sp & 255u) == 0u) { if (xb_ld(&bar[XB_TMO])) break; if (sp > XB_SPIN_CAP) { atomicAdd(&bar[XB_TMO], 1u); break; } }
    }
    nloc = mine > 0u ? mine : 1u; nx = cnt > 0u ? cnt : 1u;
}

__device__ __forceinline__ void xcd_barrier(const XcdBarrier& b) {
    asm volatile("s_waitcnt vmcnt(0)" ::: "memory");
    __syncthreads();
    if (threadIdx.x == 0) {
        unsigned* bar = b.bar;
        __builtin_amdgcn_s_waitcnt(0);
        unsigned nloc = b.st[0], nx = b.st[1];
        if (nloc == 0u) { xcd_barrier_complete(bar, b.x, nloc, nx); b.st[0] = nloc; b.st[1] = nx; }
        const unsigned old = xb_add(&bar[XB_XSUB(b.x)], 1u);
        const unsigned gen = old / nloc;
        if (old + 1u == (gen + 1u) * nloc) {
            __builtin_amdgcn_fence(__ATOMIC_RELEASE, "agent");
            asm volatile("s_waitcnt vmcnt(0)" ::: "memory");
            const unsigned og = xb_add(&bar[XB_TOP], 1u);
            const unsigned tg = og / nx;
            if (og + 1u == (tg + 1u) * nx) xb_add(&bar[XB_TOPGEN], 1u);
            else XB_SPIN(xb_ld(&bar[XB_TOPGEN]) == tg, bar);
            __builtin_amdgcn_fence(__ATOMIC_ACQUIRE, "agent");
            xb_add(&bar[XB_XGEN(b.x)], 1u);
            asm volatile("s_waitcnt vmcnt(0)" ::: "memory");
        } else {
            XB_SPIN(xb_ld(&bar[XB_XGEN(b.x)]) == gen, bar);
            __builtin_amdgcn_fence(__ATOMIC_ACQUIRE, "agent");
            asm volatile("s_waitcnt vmcnt(0)" ::: "memory");
        }
    }
    __syncthreads();
}
#ifndef NREP_ATT
#define NREP_ATT 1
#endif
#ifndef NREP_SCAN
#define NREP_SCAN 1
#endif
#ifndef NREP_G1
#define NREP_G1 1
#endif

#ifdef NO_GEMM
#define GEMM(EPI, EOBJ, AP, BP, NN, KK, LDA) do {} while(0)
#else
#define GEMM(EPI, EOBJ, AP, BP, NN, KK, LDA) do { pg8::Gemm g_{(const bf16_t*)(AP), (const bf16_t*)(BP), T, (NN), (KK), (LDA)}; pg8::StaticOrder S_; S_.init(T, (NN), G, bx); \
    pg8::gemm_phase<EPI, pg8::StaticOrder, true, true>(lds, g_, S_, EOBJ); } while (0)
#endif

__global__ void __launch_bounds__(512, 2) mega_fwd(const Args a) {
    extern __shared__ __attribute__((aligned(16))) unsigned char lds_raw[];
    cg::grid_group grid = cg::this_grid();
    LAS unsigned char* lds = (LAS unsigned char*)lds_raw;
    const Args& p = a;
    unsigned char* ws = a.ws; unsigned char* dout = (unsigned char*)a.out;
    const int tid = threadIdx.x, lane = tid & 63, wave = __builtin_amdgcn_readfirstlane(tid >> 6);
    const int G = gridDim.x, bx = blockIdx.x;
    const int vcu = (G % 8 == 0) ? (bx % 8) * (G / 8) + bx / 8 : bx;
    const int gw = vcu * 8 + wave, NGW = G * 8, gtid = bx * 512 + tid, GT = G * 512;
    bf16_t* XN = (bf16_t*)(ws + WS_U); bf16_t* ACT = (bf16_t*)(ws + WS_ACT); bf16_t* D1 = (bf16_t*)(ws + WS_D1);
    bf16_t* ZA = (bf16_t*)(ws + WS_ZA); bf16_t* ZRKV = (bf16_t*)(ws + WS_ZRKV); bf16_t* ZL = (bf16_t*)(ws + WS_ZL);
    bf16_t* MIX = (bf16_t*)(ws + WS_MIX); bf16_t* LIN = (bf16_t*)(ws + WS_LIN);
    bf16_t* Qb = (bf16_t*)(dout + DO_Q); bf16_t* Kb = (bf16_t*)(dout + DO_K); bf16_t* Vb = (bf16_t*)(dout + DO_V);
    unsigned short* WA = (unsigned short*)(dout + DO_WA); float* H = a.out;
    const float* rope = (const float*)(ws + WS_ROPE);

    volatile LAS unsigned* bst = (volatile LAS unsigned*)(lds + 131072 + 64);
    if (tid < 2) bst[tid] = 0u;
    __syncthreads();
    const XcdBarrier xbar = xcd_barrier_post((unsigned*)(ws + WS_BAR), bst);
#define GSYNC() xcd_barrier(xbar)
    prologue(p, lds, gw, NGW, wave, lane, gtid, GT, G == 256 ? 1 : 0);
    for (int m = gw; m < T; m += NGW) norm_row(xrow(p, m), nullptr, p.in[2], XN + (size_t)m * DM, nullptr, lane);
    if (a.out == nullptr) grid.sync();
    GSYNC();
#ifndef NO_EpiSwiGLU
    for (int rep_ = 0; rep_ < NREP_G1; ++rep_) { EpiSwiGLU E{ACT}; GEMM(EpiSwiGLU, E, XN, ws + WS_WGU1, 2 * DFF, DM, DM); }
#endif
    GSYNC();
#ifndef NO_EpiScaleBf16
    { EpiScaleBf16 E{D1, 0.5f}; GEMM(EpiScaleBf16, E, ACT, ws + WS_WD1, DM, DFF, DFF); }
#endif
    GSYNC();
    for (int m = gw; m < T; m += NGW) norm_row(xrow(p, m), D1 + (size_t)m * DM, p.in[6], XN + (size_t)m * DM, nullptr, lane);
    GSYNC();
#ifndef NO_EpiZ
    { EpiZ E{ZA, ZRKV, ZL}; GEMM(EpiZ, E, XN, ws + WS_WIN, 2816, DM, DM); }
#endif
    GSYNC();
    for (int m = gw; m < T; m += NGW) p5_row(p, m, lane);
    GSYNC();
#ifndef NO_EpiPlain
    { EpiPlain E{Qb, 768}; GEMM(EpiPlain, E, ZA, ws + WS_WUQ, 768, 384, 768); }
#endif
#ifndef NO_EpiKV
    { EpiKV E{Kb, Vb}; GEMM(EpiKV, E, ZA + 384, ws + WS_WUKV, 1024, 256, 768); }
#endif
    GSYNC();
#ifndef NO_ATT
    for (int rep_ = 0; rep_ < NREP_ATT; ++rep_) {
        char* ldsg = (char*)lds_raw;
        if (G == 256) {
            const int xcd = vcu >> 5, j = vcu & 31;
            for (int i = 0; i < 2; ++i) { const int head = xcd, qb = j + 32 * i; const size_t r0 = (size_t)TP + (size_t)qb * 256;
                att::attn_unit(Qb + r0 * 768 + head * 96, Kb + (size_t)TP * 768 + head * 96, Vb + (size_t)TP * 512 + head * 64, MIX + r0 * 1024 + head * 64, 16384, ldsg, rope, qb * 256); }
            for (int i = 0; i < 4; ++i) { const int pi = 4 * xcd + i, seq = pi >> 3, head = pi & 7; const size_t sb = (size_t)seq * 8192, r0 = sb + (size_t)j * 256;
                att::attn_unit(Qb + r0 * 768 + head * 96, Kb + sb * 768 + head * 96, Vb + sb * 512 + head * 64, MIX + r0 * 1024 + head * 64, 8192, ldsg, rope, j * 256); }
        } else {
            for (int u = vcu; u < 1536; u += G) {
                size_t sb, r0; int head, L;
                if (u < 512) { head = u >> 6; sb = TP; r0 = sb + (size_t)(u & 63) * 256; L = 16384; }
                else { const int v = u - 512; const int seq = v >> 8; head = (v >> 5) & 7; sb = (size_t)seq * 8192; r0 = sb + (size_t)(v & 31) * 256; L = 8192; }
                att::attn_unit(Qb + r0 * 768 + head * 96, Kb + sb * 768 + head * 96, Vb + sb * 512 + head * 64, MIX + r0 * 1024 + head * 64, L, ldsg, rope, (int)(r0 - sb));
            }
        }
    }
#endif
    GSYNC();
#ifndef NO_EpiLora
    { EpiLora E{WA, MIX, p.in[14], p.in[16], 0}; GEMM(EpiLora, E, LIN, ws + WS_WL, 1024, 128, 384); }
    { EpiLora E{WA, MIX, p.in[14], p.in[16], 2}; GEMM(EpiLora, E, LIN + 128, ws + WS_WL + 262144, 1024, 128, 384); }
    { EpiLora E{WA, MIX, p.in[14], p.in[16], 4}; GEMM(EpiLora, E, LIN + 256, ws + WS_WL + 524288, 512, 128, 384); }
#endif
    GSYNC();
#ifndef NO_SCAN
    {
        if (G == 256 && vcu >= 224) { prologue(p, lds, (vcu - 224) * 8 + wave, 32 * 8, wave, lane, 0, 1, 2);
            for (int m = (vcu - 224) * 8 + wave; m < T; m += 32 * 8) p10_att_row(p, m, lane); }
        for (int item = vcu; item < 224; item += G) {
            int sb_, L_, head_, dir_, part_ = item & 1, step0_ = 0, mode_ = 0; float* qcp_ = nullptr; float* smp_ = nullptr;
            if (item < 96) { const int kind = (item >> 1) % 3, hd = item / 6; head_ = hd >> 1; dir_ = hd & 1; sb_ = TP; L_ = 16384;
                qcp_ = (float*)(ws + (hd < 12 ? WS_QC0 + (size_t)hd * 2 * MiB : WS_QC1 + (size_t)(hd - 12) * 2 * MiB));
                if (kind == 0) smp_ = (float*)(ws + WS_SMID) + (size_t)hd * 4096; else step0_ = 8192;
                mode_ = kind == 2 ? 1 : 0; }
            else { const int j = (item - 96) >> 1; sb_ = (j >> 4) * 8192; L_ = 8192; head_ = (j >> 1) & 7; dir_ = j & 1; }
            scan_item<2, 4>(p, lds, sb_, L_, head_, dir_, part_, step0_, 8192, mode_, qcp_, smp_);
            __syncthreads();
        }
    }
    GSYNC();
    for (int it = vcu; it < 16 * 64; it += G) scan_fix_item(p, lds, it >> 6, it & 63);
#endif
    GSYNC();
    for (int m = gw; m < T; m += NGW) { if (G != 256) p10_att_row(p, m, lane); p10_row(p, m, lane); }
    GSYNC();
#ifndef NO_EpiOut
    { EpiOut E{p.in[0], p.in[1], D1}; GEMM(EpiOut, E, MIX, ws + WS_WOUT, DM, DM, DM); }
#endif
    GSYNC();
    for (int m = gw; m < T; m += NGW) norm_row_bf(D1 + (size_t)m * DM, p.in[25], XN + (size_t)m * DM, nullptr, lane);
    GSYNC();
#ifndef NO_EpiSwiGLU
    { EpiSwiGLU E{ACT}; GEMM(EpiSwiGLU, E, XN, ws + WS_WGU2, 2 * DFF, DM, DM); }
#endif
    GSYNC();
#ifndef NO_EpiDown2
    { EpiDown2 E{D1}; GEMM(EpiDown2, E, ACT, ws + WS_WD2, DM, DFF, DFF); }
#endif
    GSYNC();
    for (int m = gw; m < T; m += NGW) norm_row_bf(D1 + (size_t)m * DM, p.in[29], nullptr, H + (size_t)m * DM, lane);
}

extern "C" void kernel_launch(void* const* d_in, const int* in_sizes, int n_in, void* d_out, int out_size, void* d_ws, size_t ws_size, hipStream_t stream) {
    static int grid = 0;
    if (grid == 0) {
        if (n_in != 30 || in_sizes[0] != TP * DM || in_sizes[1] != TS * DM || out_size != T * DM || ws_size < WS_END) {
            fprintf(stderr, "kernel_launch: unexpected shapes: n_in %d in0 %d in1 %d out %d ws %zu (need >= %zu)\n", n_in, n_in > 0 ? in_sizes[0] : -1, n_in > 1 ? in_sizes[1] : -1, out_size, ws_size, (size_t)WS_END);
            grid = -1; return; }
        int dev = 0, cus = 0, per_cu = 0;
        if (hipGetDevice(&dev) != hipSuccess || hipDeviceGetAttribute(&cus, hipDeviceAttributeMultiprocessorCount, dev) != hipSuccess) { fprintf(stderr, "kernel_launch: device query failed\n"); grid = -1; return; }
        if (hipFuncSetAttribute((const void*)mega_fwd, hipFuncAttributeMaxDynamicSharedMemorySize, LDS_BYTES) != hipSuccess) { fprintf(stderr, "kernel_launch: hipFuncSetAttribute failed\n"); grid = -1; return; }
        if (hipOccupancyMaxActiveBlocksPerMultiprocessor(&per_cu, (const void*)mega_fwd, 512, LDS_BYTES) != hipSuccess || per_cu < 1) { fprintf(stderr, "kernel_launch: occupancy query says %d\n", per_cu); per_cu = 1; }
        (void)hipGetLastError();
        grid = cus * 1;
    }
    if (grid < 0) return;
    (void)hipMemsetAsync((char*)d_ws + WS_CTL, 0, WS_ZERO_BYTES, stream);
    Args a{};
    for (int i = 0; i < 30; ++i) a.in[i] = (const float*)d_in[i];
    a.out = (float*)d_out; a.ws = (unsigned char*)d_ws;
    void* args[] = {&a};
    hipError_t e = hipLaunchCooperativeKernel((const void*)mega_fwd, dim3(grid), dim3(512), args, LDS_BYTES, stream);
    if (e != hipSuccess) fprintf(stderr, "kernel_launch: cooperative launch failed: %s (grid %d)\n", hipGetErrorString(e), grid);
}
```

```cpp
#include <hip/hip_runtime.h>
#include <hip/hip_cooperative_groups.h>
#include <hip/hip_bf16.h>
#include <cstdio>
#include <cstdint>
namespace cg = cooperative_groups;
namespace pg8 {
#define PG8_LAS __attribute__((address_space(3)))
typedef unsigned short bf16_t;
typedef short bf16x8 __attribute__((ext_vector_type(8)));
typedef float f32x4 __attribute__((ext_vector_type(4)));
typedef unsigned u32x4 __attribute__((ext_vector_type(4)));
constexpr int BM = 256, BK = 64, HALF = 128, HTB = HALF * BK * 2  , STAGE_BYTES = 8 * HTB, NXCD = 8, WGM = 8;

__host__ __device__ __forceinline__ int lds_byte(int r, int c) { const int st = (r >> 4) * 2 + (c >> 5), rr = r & 15, cc = c & 31, ob = rr * 64 + cc * 2; return st * 1024 + (ob ^ (((ob >> 9) & 1) << 5)); }
__host__ __device__ __forceinline__ void stage_rc(int b, int& R, int& C) { const int st = b / 1024, sb = b % 1024, swz = sb ^ (((sb >> 9) & 1) << 5); R = (st >> 1) * 16 + swz / 64; C = (st & 1) * 32 + (swz % 64) / 2; }
__host__ __device__ __forceinline__ int perm32(int rho) { const int n = rho >> 4, i = rho & 15; return 8 * (i >> 2) + 4 * n + (i & 3); }

struct Unit { int pm, pn; };
struct Gemm { const bf16_t* A; const bf16_t* Bt; int M, N, K, lda; };

struct StaticOrder {
    int nM, nN, nwg, G, c;
    __host__ __device__ void init(int M, int N, int G_, int c_) { nM = M / BM; nN = N / BM; nwg = nM * nN; G = G_; c = c_; }
    __host__ __device__ bool next(int i, Unit& u) const {
        const long L = (long)i * G + c; if (L >= nwg) return false;
        int wgid = (int)L; { const int q = nwg / NXCD, r = nwg % NXCD, xcd = wgid % NXCD, off = wgid / NXCD; wgid = (xcd < r ? xcd * (q + 1) : r * (q + 1) + (xcd - r) * q) + off; }
        const int nig = WGM * nN, gid = wgid / nig, fm = gid * WGM, gsz = (nM - fm) < WGM ? (nM - fm) : WGM;
        u.pm = fm + ((wgid % nig) % gsz); u.pn = (wgid % nig) / gsz; return true;
    }
    __device__ __forceinline__ void a_ready(const Unit&) const {}
    __device__ __forceinline__ void done(const Unit&) const {}
};

__device__ __forceinline__ unsigned cvt_pk_bf16(float lo, float hi) { unsigned r; asm volatile("v_cvt_pk_bf16_f32 %0, %1, %2" : "=v"(r) : "v"(lo), "v"(hi)); return r; }
typedef float f32x2 __attribute__((ext_vector_type(2)));
template <class Epi, class Sched, bool ALIGN_EPI = false, bool SP2 = false>
__device__ __forceinline__ void gemm_phase(PG8_LAS unsigned char* lds, const Gemm g, const Sched& S, const Epi& E) {
    int tid_ = threadIdx.x; asm volatile("" : "+v"(tid_));
    const int tid = tid_, wid = __builtin_amdgcn_readfirstlane(tid >> 6), lane = tid & 63, wr = wid >> 2, wc = wid & 3, fr = lane & 15, fq = lane >> 4;
    int K_ = g.K; asm volatile("" : "+s"(K_));
    const int K = K_, nt = K / BK;
    unsigned voffA[2], voffB[2];
#pragma unroll
    for (int i = 0; i < 2; ++i) { int R, C; stage_rc(tid * 16 + i * 8192, R, C); const int Rb = Epi::PERM ? ((R & ~31) + perm32(R & 31)) : R;
        voffA[i] = (unsigned)(R * g.lda + C) * 2u; voffB[i] = (unsigned)(Rb * K + C) * 2u; }
    const size_t kstep = (size_t)(BK * 2);
    const size_t hstepB = (size_t)HALF * K * 2, hstepA = (size_t)HALF * g.lda * 2;
    const size_t tstepA = 2 * hstepA, tstepB = 2 * hstepB;
    const unsigned ldsw = (unsigned)wid * 1024u;
    const int aoff = lds_byte(wr * 64 + fr, fq * 8), boff = lds_byte(wc * 32 + fr, fq * 8);
#define PG8_SA(b, h) (((b) * 2 + (h)) * HTB)
#define PG8_SB(b, h) ((4 + (b) * 2 + (h)) * HTB)
#define PG8_STAGE(bufoff, gbase, voff) do { _Pragma("unroll") for (int _i = 0; _i < 2; ++_i) \
        __builtin_amdgcn_global_load_lds((const unsigned*)((const char*)(gbase) + (voff)[_i]), (PG8_LAS unsigned*)(lds + (bufoff) + ldsw + _i * 8192), 16, 0, 0); } while (0)
#define PG8_LDA(dst, b, h) do { _Pragma("unroll") for (int m = 0; m < 4; ++m) _Pragma("unroll") for (int k = 0; k < 2; ++k) dst[m][k] = *(const PG8_LAS bf16x8*)(lds + PG8_SA(b, h) + aoff + m * 2048 + k * 1024); } while (0)
#define PG8_LDB(dst, b, h) do { _Pragma("unroll") for (int n = 0; n < 2; ++n) _Pragma("unroll") for (int k = 0; k < 2; ++k) dst[n][k] = *(const PG8_LAS bf16x8*)(lds + PG8_SB(b, h) + boff + n * 2048 + k * 1024); } while (0)
#define PG8_MMA(ai, bj, At, Bt) do { __builtin_amdgcn_s_setprio(1); _Pragma("unroll") for (int m = 0; m < 4; ++m) _Pragma("unroll") for (int n = 0; n < 2; ++n) _Pragma("unroll") for (int k = 0; k < 2; ++k) \
        acc[ai][bj][m][n] = __builtin_amdgcn_mfma_f32_16x16x32_bf16(Bt[n][k], At[m][k], acc[ai][bj][m][n], 0, 0, 0); __builtin_amdgcn_s_setprio(0); } while (0)
#define PG8_WAIT_V(n) asm volatile("s_waitcnt vmcnt(" #n ")" ::: "memory")
#define PG8_WAIT_L(n) asm volatile("s_waitcnt lgkmcnt(" #n ")" ::: "memory")
#define PG8_BAR __builtin_amdgcn_s_barrier()
#define PG8_SCHED __builtin_amdgcn_sched_barrier(0)
    Unit cur, nxt; int ui = 0;
    if (!S.next(0, cur)) return;
    f32x4 acc[2][2][4][2];
#pragma unroll
    for (int a = 0; a < 2; ++a)
#pragma unroll
        for (int b = 0; b < 2; ++b)
#pragma unroll
            for (int m = 0; m < 4; ++m)
#pragma unroll
                for (int n = 0; n < 2; ++n) acc[a][b][m][n] = (f32x4){0.f, 0.f, 0.f, 0.f};
    bf16x8 At[4][2], B0[2][2], B1[2][2];
    const char* cA = (const char*)g.A + (size_t)cur.pm * tstepA; const char* cB = (const char*)g.Bt + (size_t)cur.pn * tstepB;
    S.a_ready(cur);
    if constexpr (SP2) {
        PG8_STAGE(PG8_SB(0, 0), cB, voffB); PG8_STAGE(PG8_SB(0, 1), cB + hstepB, voffB); PG8_STAGE(PG8_SA(0, 0), cA, voffA); PG8_STAGE(PG8_SA(0, 1), cA + hstepA, voffA);
        if (wr == 1) PG8_BAR;
        PG8_WAIT_V(2); PG8_BAR;
        PG8_STAGE(PG8_SB(1, 0), cB + kstep, voffB); PG8_STAGE(PG8_SA(1, 0), cA + kstep, voffA); PG8_STAGE(PG8_SB(1, 1), cB + hstepB + kstep, voffB);
        PG8_WAIT_V(6); PG8_BAR;
    } else {
        PG8_STAGE(PG8_SB(0, 0), cB, voffB); PG8_STAGE(PG8_SA(0, 0), cA, voffA); PG8_STAGE(PG8_SB(0, 1), cB + hstepB, voffB); PG8_STAGE(PG8_SA(0, 1), cA + hstepA, voffA);
        if (wr == 1) PG8_BAR;
        PG8_WAIT_V(4); PG8_BAR;
        PG8_STAGE(PG8_SB(1, 0), cB + kstep, voffB); PG8_STAGE(PG8_SA(1, 0), cA + kstep, voffA); PG8_STAGE(PG8_SB(1, 1), cB + hstepB + kstep, voffB);
        PG8_WAIT_V(6); PG8_BAR;
    }
    for (;;) {
        const bool has_next = S.next(ui + 1, nxt);
        const char* nA = has_next ? (const char*)g.A + (size_t)nxt.pm * tstepA : cA; const char* nB = has_next ? (const char*)g.Bt + (size_t)nxt.pn * tstepB : cB;
        for (int t = 0; t < nt; t += 2) {
            const bool last = (t == nt - 2);
            const char* a1 = cA + (size_t)(t + 1) * kstep;
            const char* a2 = last ? nA : cA + (size_t)(t + 2) * kstep; const char* b2 = last ? nB : cB + (size_t)(t + 2) * kstep;
            const char* a3 = a2 + kstep; const char* b3 = b2 + kstep;
            if (last && has_next) S.a_ready(nxt);
            if constexpr (SP2) {
            PG8_LDB(B0, 0, 0); PG8_LDB(B1, 0, 1); PG8_SCHED; PG8_LDA(At, 0, 0); PG8_STAGE(PG8_SA(1, 1), a1 + hstepA, voffA);
            PG8_WAIT_V(8); PG8_WAIT_L(0); PG8_BAR; PG8_MMA(0, 0, At, B0); PG8_MMA(0, 1, At, B1); PG8_BAR; PG8_SCHED;
            PG8_LDA(At, 0, 1); PG8_STAGE(PG8_SB(0, 0), b2, voffB); PG8_STAGE(PG8_SB(0, 1), b2 + hstepB, voffB); PG8_STAGE(PG8_SA(0, 0), a2, voffA);
            PG8_WAIT_V(8); PG8_WAIT_L(0); PG8_BAR; PG8_MMA(1, 0, At, B0); PG8_MMA(1, 1, At, B1); PG8_BAR; PG8_SCHED;
            PG8_LDB(B0, 1, 0); PG8_LDB(B1, 1, 1); PG8_SCHED; PG8_LDA(At, 1, 0); PG8_STAGE(PG8_SA(0, 1), a2 + hstepA, voffA);
            PG8_WAIT_V(8); PG8_WAIT_L(0); PG8_BAR; PG8_MMA(0, 0, At, B0); PG8_MMA(0, 1, At, B1); PG8_BAR; PG8_SCHED;
            PG8_LDA(At, 1, 1); PG8_STAGE(PG8_SB(1, 0), b3, voffB); PG8_STAGE(PG8_SB(1, 1), b3 + hstepB, voffB); PG8_STAGE(PG8_SA(1, 0), a3, voffA);
            PG8_WAIT_V(8); PG8_WAIT_L(0); PG8_BAR; PG8_MMA(1, 0, At, B0); PG8_MMA(1, 1, At, B1); PG8_BAR; PG8_SCHED;
            } else {
            PG8_LDB(B0, 0, 0); PG8_SCHED; PG8_LDA(At, 0, 0); PG8_STAGE(PG8_SA(1, 1), a1 + hstepA, voffA);
            PG8_WAIT_L(8); PG8_BAR; PG8_WAIT_L(0); PG8_MMA(0, 0, At, B0); PG8_BAR; PG8_SCHED;
            PG8_LDB(B1, 0, 1); PG8_STAGE(PG8_SB(0, 0), b2, voffB);
            PG8_BAR; PG8_WAIT_L(0); PG8_MMA(0, 1, At, B1); PG8_BAR;
            PG8_LDA(At, 0, 1); PG8_STAGE(PG8_SA(0, 0), a2, voffA);
            PG8_BAR; PG8_WAIT_L(0); PG8_MMA(1, 0, At, B0); PG8_BAR; PG8_SCHED;
            PG8_STAGE(PG8_SB(0, 1), b2 + hstepB, voffB);
            PG8_WAIT_V(6); PG8_BAR; PG8_MMA(1, 1, At, B1); PG8_BAR;
            PG8_LDB(B0, 1, 0); PG8_SCHED; PG8_LDA(At, 1, 0); PG8_STAGE(PG8_SA(0, 1), a2 + hstepA, voffA);
            PG8_WAIT_L(8); PG8_BAR; PG8_WAIT_L(0); PG8_MMA(0, 0, At, B0); PG8_BAR; PG8_SCHED;
            PG8_LDB(B1, 1, 1); PG8_STAGE(PG8_SB(1, 0), b3, voffB);
            PG8_BAR; PG8_WAIT_L(0); PG8_MMA(0, 1, At, B1); PG8_BAR;
            PG8_LDA(At, 1, 1); PG8_STAGE(PG8_SA(1, 0), a3, voffA);
            PG8_BAR; PG8_WAIT_L(0); PG8_MMA(1, 0, At, B0); PG8_BAR; PG8_SCHED;
            PG8_STAGE(PG8_SB(1, 1), b3 + hstepB, voffB);
            PG8_WAIT_V(6); PG8_BAR; PG8_MMA(1, 1, At, B1); PG8_BAR;
            }
        }
        if constexpr (ALIGN_EPI) { if (wr == 0) PG8_BAR; }
        if constexpr (!Epi::AFTER_DRAIN) { E(acc, cur, wr, wc, fr, fq); S.done(cur); }
        if (!has_next) break;
#pragma unroll
        for (int a = 0; a < 2; ++a)
#pragma unroll
            for (int b = 0; b < 2; ++b)
#pragma unroll
                for (int m = 0; m < 4; ++m)
#pragma unroll
                    for (int n = 0; n < 2; ++n) acc[a][b][m][n] = (f32x4){0.f, 0.f, 0.f, 0.f};
        cur = nxt; cA = nA; cB = nB; ++ui;
        if constexpr (ALIGN_EPI) { if (wr == 1) PG8_BAR; }
    }
    PG8_WAIT_V(0);
    if constexpr (!ALIGN_EPI) { if (wr == 0) PG8_BAR; }
    PG8_BAR;
    if constexpr (Epi::AFTER_DRAIN) { E.fused(acc, cur, wr, wc, fr, fq, lds, wid, lane); S.done(cur); }
#undef PG8_SA
#undef PG8_SB
#undef PG8_STAGE
#undef PG8_LDA
#undef PG8_LDB
#undef PG8_MMA
#undef PG8_WAIT_V
#undef PG8_WAIT_L
#undef PG8_BAR
#undef PG8_SCHED
}
}

#define LAS __attribute__((address_space(3)))
typedef unsigned short bf16_t;
typedef float f32x4 __attribute__((ext_vector_type(4)));
typedef unsigned u32x4 __attribute__((ext_vector_type(4)));
typedef unsigned u32x2 __attribute__((ext_vector_type(2)));
typedef _Float16 h16x2 __attribute__((ext_vector_type(2)));
constexpr int DM = 1024, TP = 32768, TS = 16384, T = TP + TS, DFF = 2816, NH = 8;
constexpr float NORM_EPS = 1e-6f, LNX_EPS = 64e-5f;
constexpr size_t MiB = 1u << 20;
constexpr size_t WS_CTL = 0, WS_WL = 1 * MiB, WS_ZERO_BYTES = 3 * MiB, WS_ROPE = 3 * MiB;
constexpr size_t WS_WGU1 = 5 * MiB, WS_WD1 = 16 * MiB, WS_WGU2 = 21 * MiB + MiB / 2, WS_WD2 = 32 * MiB + MiB / 2, WS_WIN = 38 * MiB,
                 WS_WUQ = 43 * MiB + MiB / 2, WS_WUKV = WS_WUQ + 9 * MiB / 16, WS_WOUT = WS_WUKV + MiB / 2;
constexpr size_t WS_D1 = 48 * MiB, WS_ZRKV = 144 * MiB, WS_ZA = 288 * MiB, WS_ZL = 360 * MiB, WS_U = 408 * MiB, WS_END = 512 * MiB;
constexpr size_t WS_ACT = 144 * MiB, WS_MIX = 288 * MiB, WS_LIN = 408 * MiB, WS_Y = 408 * MiB;
constexpr size_t WS_BAR = 512 * 1024;
constexpr size_t WS_SMID = 0, WS_QC0 = 384 * MiB, WS_QC1 = 504 * MiB;
constexpr size_t WS_BS = 1 * MiB;
constexpr size_t DO_Q = 0, DO_K = 72 * MiB, DO_V = 144 * MiB, DO_WA = 0;
static_assert(WS_WOUT + 2 * MiB <= WS_D1, "weights overflow");
constexpr int LDS_BYTES = 147456;

__device__ const float ROPE_INV[16] = {1.000000000e+00f, 5.623413324e-01f, 3.162277639e-01f, 1.778279394e-01f, 1.000000015e-01f, 5.623412877e-02f, 3.162277862e-02f, 1.778279431e-02f,
                                       9.999999776e-03f, 5.623413250e-03f, 3.162277862e-03f, 1.778279431e-03f, 1.000000047e-03f, 5.623413017e-04f, 3.162277862e-04f, 1.778279402e-04f};

__device__ __forceinline__ float bflo(unsigned w) { return __uint_as_float(w << 16); }
__device__ __forceinline__ float bfhi(unsigned w) { return __uint_as_float(w & 0xffff0000u); }
__device__ __forceinline__ unsigned pkbf(float lo, float hi) { return pg8::cvt_pk_bf16(lo, hi); }
__device__ __forceinline__ unsigned pkh(float lo, float hi) { h16x2 v; v.x = (_Float16)lo; v.y = (_Float16)hi; return __builtin_bit_cast(unsigned, v); }
__device__ __forceinline__ float hlo(unsigned w) { h16x2 v = __builtin_bit_cast(h16x2, w); return (float)v.x; }
__device__ __forceinline__ float hhi(unsigned w) { h16x2 v = __builtin_bit_cast(h16x2, w); return (float)v.y; }
__device__ __forceinline__ void unpack8bf(const u32x4 w, float* f) { f[0] = bflo(w.x); f[1] = bfhi(w.x); f[2] = bflo(w.y); f[3] = bfhi(w.y); f[4] = bflo(w.z); f[5] = bfhi(w.z); f[6] = bflo(w.w); f[7] = bfhi(w.w); }
__device__ __forceinline__ void unpack8h(const u32x4 w, float* f) { f[0] = hlo(w.x); f[1] = hhi(w.x); f[2] = hlo(w.y); f[3] = hhi(w.y); f[4] = hlo(w.z); f[5] = hhi(w.z); f[6] = hlo(w.w); f[7] = hhi(w.w); }
__device__ __forceinline__ float wave_sum(float v) {
#pragma unroll
    for (int o = 1; o < 64; o <<= 1) v += __shfl_xor(v, o);
    return v;
}
__device__ __forceinline__ float fsigmoid(float x) { return __builtin_amdgcn_rcpf(1.f + __builtin_amdgcn_exp2f(-1.4426950408889634f * x)); }
__device__ __forceinline__ int seq_pos(int row) { return row < TP ? (row & 8191) : (row - TP); }

using pg8::Unit;
typedef const pg8::f32x4 (&AccRef)[2][2][4][2];

struct EpiSwiGLU {
    static constexpr bool PERM = true, AFTER_DRAIN = false; bf16_t* O;
    __device__ __forceinline__ void operator()(AccRef acc, const Unit& u, int wr, int wc, int fr, int fq) const {
        asm volatile("" : "+v"(fr), "+v"(fq));
        const int row0 = u.pm * 256 + wr * 64 + fr, col0 = u.pn * 128 + wc * 32 + 8 * fq;
#pragma unroll
        for (int ai = 0; ai < 2; ++ai)
#pragma unroll
            for (int m = 0; m < 4; ++m) {
                bf16_t* rowp = O + (size_t)(row0 + ai * 128 + m * 16) * DFF + col0;
                float o[8];
#pragma unroll
                for (int n = 0; n < 2; ++n)
#pragma unroll
                    for (int e = 0; e < 4; ++e) { const float g = acc[ai][0][m][n][e], up = acc[ai][1][m][n][e]; o[n * 4 + e] = g * fsigmoid(g) * up; }
                u32x4 w; w.x = pkbf(o[0], o[1]); w.y = pkbf(o[2], o[3]); w.z = pkbf(o[4], o[5]); w.w = pkbf(o[6], o[7]);
                *(u32x4*)rowp = w; __builtin_amdgcn_sched_barrier(0); asm volatile("" ::: "memory");
            }
    }
};
struct EpiScaleBf16 {
    static constexpr bool PERM = true, AFTER_DRAIN = false; bf16_t* O; float s;
    __device__ __forceinline__ void operator()(AccRef acc, const Unit& u, int wr, int wc, int fr, int fq) const {
        asm volatile("" : "+v"(fr), "+v"(fq));
        const int row0 = u.pm * 256 + wr * 64 + fr, col0 = u.pn * 256 + wc * 32 + 8 * fq;
#pragma unroll
        for (int ai = 0; ai < 2; ++ai)
#pragma unroll
            for (int m = 0; m < 4; ++m)
#pragma unroll
                for (int bj = 0; bj < 2; ++bj) {
                    const pg8::f32x4 v0 = acc[ai][bj][m][0] * s, v1 = acc[ai][bj][m][1] * s;
                    u32x4 w; w.x = pkbf(v0[0], v0[1]); w.y = pkbf(v0[2], v0[3]); w.z = pkbf(v1[0], v1[1]); w.w = pkbf(v1[2], v1[3]);
                    *(u32x4*)(O + (size_t)(row0 + ai * 128 + m * 16) * DM + col0 + bj * 128) = w; __builtin_amdgcn_sched_barrier(0); asm volatile("" ::: "memory");
                }
    }
};
struct EpiZ {
    static constexpr bool PERM = true, AFTER_DRAIN = false; bf16_t *ZA, *ZRKV, *ZL;
    __device__ __forceinline__ void operator()(AccRef acc, const Unit& u, int wr, int wc, int fr, int fq) const {
        asm volatile("" : "+v"(fr), "+v"(fq));
        bf16_t* base; int ldc, colt;
        if (u.pn < 3) { base = ZA; ldc = 768; colt = u.pn * 256; } else if (u.pn < 9) { base = ZRKV; ldc = 1536; colt = (u.pn - 3) * 256; } else { base = ZL; ldc = 512; colt = (u.pn - 9) * 256; }
        const int row0 = u.pm * 256 + wr * 64 + fr, col0 = colt + wc * 32 + 8 * fq;
#pragma unroll
        for (int ai = 0; ai < 2; ++ai)
#pragma unroll
            for (int m = 0; m < 4; ++m)
#pragma unroll
                for (int bj = 0; bj < 2; ++bj) {
                    const pg8::f32x4 v0 = acc[ai][bj][m][0], v1 = acc[ai][bj][m][1];
                    u32x4 w; w.x = pkbf(v0[0], v0[1]); w.y = pkbf(v0[2], v0[3]); w.z = pkbf(v1[0], v1[1]); w.w = pkbf(v1[2], v1[3]);
                    *(u32x4*)(base + (size_t)(row0 + ai * 128 + m * 16) * ldc + col0 + bj * 128) = w; __builtin_amdgcn_sched_barrier(0); asm volatile("" ::: "memory");
                }
    }
};
struct EpiPlain {
    static constexpr bool PERM = true, AFTER_DRAIN = false; bf16_t* O; int ldc;
    __device__ __forceinline__ void operator()(AccRef acc, const Unit& u, int wr, int wc, int fr, int fq) const {
        asm volatile("" : "+v"(fr), "+v"(fq));
        const int row0 = u.pm * 256 + wr * 64 + fr, col0 = u.pn * 256 + wc * 32 + 8 * fq;
#pragma unroll
        for (int ai = 0; ai < 2; ++ai)
#pragma unroll
            for (int m = 0; m < 4; ++m)
#pragma unroll
                for (int bj = 0; bj < 2; ++bj) {
                    const pg8::f32x4 v0 = acc[ai][bj][m][0], v1 = acc[ai][bj][m][1];
                    u32x4 w; w.x = pkbf(v0[0], v0[1]); w.y = pkbf(v0[2], v0[3]); w.z = pkbf(v1[0], v1[1]); w.w = pkbf(v1[2], v1[3]);
                    *(u32x4*)(O + (size_t)(row0 + ai * 128 + m * 16) * ldc + col0 + bj * 128) = w;
                }
    }
};
struct EpiKV {
    static constexpr bool PERM = true, AFTER_DRAIN = false; bf16_t *K, *V;
    __device__ __forceinline__ void operator()(AccRef acc, const Unit& u, int wr, int wc, int fr, int fq) const {
        asm volatile("" : "+v"(fr), "+v"(fq));
        const int row0 = u.pm * 256 + wr * 64 + fr;
        const bool isk = u.pn < 2; bf16_t* base = isk ? K : V; const int ldc = isk ? 768 : 512;
#pragma unroll
        for (int bj = 0; bj < 2; ++bj) {
            const int c0 = (u.pn & 1) * 256 + bj * 128 + wc * 32 + 8 * fq;
            const int cc = isk ? (c0 >> 6) * 96 + (c0 & 63) : c0;
#pragma unroll
            for (int ai = 0; ai < 2; ++ai)
#pragma unroll
                for (int m = 0; m < 4; ++m) {
                    const pg8::f32x4 v0 = acc[ai][bj][m][0], v1 = acc[ai][bj][m][1];
                    u32x4 w; w.x = pkbf(v0[0], v0[1]); w.y = pkbf(v0[2], v0[3]); w.z = pkbf(v1[0], v1[1]); w.w = pkbf(v1[2], v1[3]);
                    *(u32x4*)(base + (size_t)(row0 + ai * 128 + m * 16) * ldc + cc) = w;
                }
        }
    }
};
struct EpiLora {
    static constexpr bool PERM = true, AFTER_DRAIN = false; unsigned short* WA; bf16_t* MIX; const float *w0, *a0; int seg0;
    template <int MODE> __device__ __forceinline__ void run(AccRef acc, const Unit& u, int wr, int wc, int fr, int fq) const {
        const int row0 = u.pm * 256 + wr * 64 + fr, seg = seg0 + (u.pn >> 1);
#pragma unroll
        for (int bj = 0; bj < 2; ++bj) {
            const int cc = (u.pn & 1) * 256 + bj * 128 + wc * 32 + 8 * fq;
            float bias[8];
            if (MODE < 2) { const float* bp = (MODE == 0 ? w0 + seg * 512 : a0 + (seg - 2) * 512) + cc; const f32x4 b0 = *(const f32x4*)bp, b1 = *(const f32x4*)(bp + 4);
                bias[0] = b0[0]; bias[1] = b0[1]; bias[2] = b0[2]; bias[3] = b0[3]; bias[4] = b1[0]; bias[5] = b1[1]; bias[6] = b1[2]; bias[7] = b1[3]; }
            else {
#pragma unroll
                for (int e = 0; e < 8; ++e) bias[e] = 0.f; }
#pragma unroll
            for (int ai = 0; ai < 2; ++ai)
#pragma unroll
                for (int m = 0; m < 4; ++m) {
                    const int row = row0 + ai * 128 + m * 16;
                    float x[8];
#pragma unroll
                    for (int e = 0; e < 4; ++e) { x[e] = acc[ai][bj][m][0][e] + bias[e]; x[4 + e] = acc[ai][bj][m][1][e] + bias[4 + e]; }
                    u32x4 w;
                    if (MODE == 0) {
#pragma unroll
                        for (int e = 0; e < 8; ++e) { const float sp = __logf(1.f + __expf(-x[e])); x[e] = __expf(-__expf(-sp - 0.5f)); }
                        w.x = pkh(x[0], x[1]); w.y = pkh(x[2], x[3]); w.z = pkh(x[4], x[5]); w.w = pkh(x[6], x[7]);
                        *(u32x4*)(WA + (size_t)row * 2048 + seg * 512 + cc) = w;
                    } else if (MODE == 1) {
#pragma unroll
                        for (int e = 0; e < 8; ++e) x[e] = fsigmoid(x[e]);
                        w.x = pkh(x[0], x[1]); w.y = pkh(x[2], x[3]); w.z = pkh(x[4], x[5]); w.w = pkh(x[6], x[7]);
                        *(u32x4*)(WA + (size_t)row * 2048 + seg * 512 + cc) = w;
                    } else {
                        w.x = pkbf(x[0], x[1]); w.y = pkbf(x[2], x[3]); w.z = pkbf(x[4], x[5]); w.w = pkbf(x[6], x[7]);
                        *(u32x4*)(MIX + (size_t)row * 1024 + 512 + cc) = w;
                    }
                    __builtin_amdgcn_sched_barrier(0); asm volatile("" ::: "memory");
                }
        }
    }
    __device__ __forceinline__ void operator()(AccRef acc, const Unit& u, int wr, int wc, int fr, int fq) const {
        asm volatile("" : "+v"(fr), "+v"(fq));
        const int seg = seg0 + (u.pn >> 1);
        if (seg < 2) run<0>(acc, u, wr, wc, fr, fq); else if (seg < 4) run<1>(acc, u, wr, wc, fr, fq); else run<2>(acc, u, wr, wc, fr, fq);
    }
};
struct EpiOut {
    static constexpr bool PERM = true, AFTER_DRAIN = false; const float *xp, *xs; bf16_t* D1;
    __device__ __forceinline__ void operator()(AccRef acc, const Unit& u, int wr, int wc, int fr, int fq) const {
        asm volatile("" : "+v"(fr), "+v"(fq));
        const int row0 = u.pm * 256 + wr * 64 + fr, col0 = u.pn * 256 + wc * 32 + 8 * fq;
        const float* xb = (u.pm * 256 < TP) ? xp : xs - (size_t)TP * DM;
#pragma unroll
        for (int ai = 0; ai < 2; ++ai)
#pragma unroll
            for (int m = 0; m < 4; ++m)
#pragma unroll
                for (int bj = 0; bj < 2; ++bj) {
                    const size_t off = (size_t)(row0 + ai * 128 + m * 16) * DM + col0 + bj * 128;
                    const f32x4 x0 = *(const f32x4*)(xb + off), x1 = *(const f32x4*)(xb + off + 4);
                    const u32x4 dw = *(const u32x4*)(D1 + off); float d[8]; unpack8bf(dw, d);
                    float o[8];
#pragma unroll
                    for (int e = 0; e < 4; ++e) { o[e] = x0[e] + d[e] + acc[ai][bj][m][0][e]; o[4 + e] = x1[e] + d[4 + e] + acc[ai][bj][m][1][e]; }
                    u32x4 w; w.x = pkbf(o[0], o[1]); w.y = pkbf(o[2], o[3]); w.z = pkbf(o[4], o[5]); w.w = pkbf(o[6], o[7]);
                    *(u32x4*)(D1 + off) = w;
                }
    }
};
struct EpiDown2 {
    static constexpr bool PERM = true, AFTER_DRAIN = false; bf16_t* Hb;
    __device__ __forceinline__ void operator()(AccRef acc, const Unit& u, int wr, int wc, int fr, int fq) const {
        asm volatile("" : "+v"(fr), "+v"(fq));
        const int row0 = u.pm * 256 + wr * 64 + fr, col0 = u.pn * 256 + wc * 32 + 8 * fq;
#pragma unroll
        for (int ai = 0; ai < 2; ++ai)
#pragma unroll
            for (int m = 0; m < 4; ++m)
#pragma unroll
                for (int bj = 0; bj < 2; ++bj) {
                    const size_t off = (size_t)(row0 + ai * 128 + m * 16) * DM + col0 + bj * 128;
                    const u32x4 hw = *(const u32x4*)(Hb + off); float h[8]; unpack8bf(hw, h);
#pragma unroll
                    for (int e = 0; e < 4; ++e) { h[e] += 0.5f * acc[ai][bj][m][0][e]; h[4 + e] += 0.5f * acc[ai][bj][m][1][e]; }
                    u32x4 w; w.x = pkbf(h[0], h[1]); w.y = pkbf(h[2], h[3]); w.z = pkbf(h[4], h[5]); w.w = pkbf(h[6], h[7]);
                    *(u32x4*)(Hb + off) = w;
                }
    }
};

__device__ __forceinline__ void transpose_item(const float* W, int N, int k0, int n0, bf16_t* WT, int ldk, int kdst0, int drow0, bool ropeperm, LAS float* scr, int lane, float sc = 1.f) {
#pragma unroll 8
    for (int i = 0; i < 32; ++i) { const int kk = 2 * i + (lane >> 5); scr[kk * 33 + (lane & 31)] = W[(size_t)(k0 + kk) * N + n0 + (lane & 31)]; }
    asm volatile("s_waitcnt lgkmcnt(0)" ::: "memory");
    const int c = lane & 7;
#pragma unroll
    for (int j = 0; j < 4; ++j) { const int n = (lane >> 3) + 8 * j; const LAS float* s = scr + (8 * c) * 33 + n;
        u32x4 o; o.x = pkbf(s[0 * 33] * sc, s[1 * 33] * sc); o.y = pkbf(s[2 * 33] * sc, s[3 * 33] * sc); o.z = pkbf(s[4 * 33] * sc, s[5 * 33] * sc); o.w = pkbf(s[6 * 33] * sc, s[7 * 33] * sc);
        const int dn = ropeperm ? (n < 16 ? 2 * n : 2 * (n - 16) + 1) : n;
        *(u32x4*)(WT + (size_t)(drow0 + dn) * ldk + kdst0 + k0 + 8 * c) = o; }
    asm volatile("s_waitcnt lgkmcnt(0)" ::: "memory");
}

struct Args { const float* in[30]; float* out; unsigned char* ws; };
typedef Args P;
__device__ __forceinline__ const float* xrow(const P& p, int row) { return row < TP ? p.in[0] + (size_t)row * DM : p.in[1] + (size_t)(row - TP) * DM; }

__device__ __forceinline__ void prologue(const P& p, LAS unsigned char* lds, int gw, int NGW, int wave, int lane, int gtid, int GT, int which) {
    LAS float* scr = (LAS float*)(lds + wave * 16384);
    unsigned char* ws = p.ws;
    constexpr int I_G = 16 * 88, I_D = 44 * 32, I_IN = 16 * 81, I_UQ = 6 * 24, I_UKV = 4 * 32, I_OUT = 16 * 32, I_L = 16, I_GL = 2 * 16;
    constexpr int NITEMS = 4 * I_G + 2 * I_D + I_IN + I_UQ + I_UKV + I_OUT + 4 * I_L + I_GL;
    for (int it = gw; it < NITEMS; it += NGW) {
        int r = it;
        if (r < 2 * (2 * I_G + I_D)) {
            const int f = r >= (2 * I_G + I_D) ? 1 : 0; r -= f * (2 * I_G + I_D);
            if ((which == 1 && f == 1) || (which == 2 && f == 0)) continue;
            bf16_t* WGU = (bf16_t*)(ws + (f ? WS_WGU2 : WS_WGU1)); bf16_t* WD = (bf16_t*)(ws + (f ? WS_WD2 : WS_WD1));
            const float* wg = p.in[f ? 26 : 3]; const float* wu = p.in[f ? 27 : 4]; const float* wd = p.in[f ? 28 : 5];
            if (r < 2 * I_G) { const bool up = r >= I_G; const int q = up ? r - I_G : r; const int kb = q / 88, nb = q % 88, n0 = nb * 32;
                transpose_item(up ? wu : wg, DFF, kb * 64, n0, WGU, DM, 0, (n0 >> 7) * 256 + (n0 & 127) + (up ? 128 : 0), false, scr, lane); }
            else { r -= 2 * I_G; const int kb = r / 32, nb = r % 32; transpose_item(wd, DM, kb * 64, nb * 32, WD, DFF, 0, nb * 32, false, scr, lane); }
            continue;
        }
        r -= 2 * (2 * I_G + I_D);
        { const bool is_out = (r >= I_IN + I_UQ + I_UKV) && (r < I_IN + I_UQ + I_UKV + I_OUT); if ((which == 1 && is_out) || (which == 2 && !is_out)) continue; }
        if (r < I_IN) { const int kb = r / 81, nb = r % 81, n0 = nb * 32; const int dr = n0 < 672 ? n0 : (n0 < 2208 ? 768 + (n0 - 672) : 2304 + (n0 - 2208));
            transpose_item(p.in[7], 2592, kb * 64, n0, (bf16_t*)(ws + WS_WIN), DM, 0, dr, false, scr, lane); continue; }
        r -= I_IN;
        if (r < I_UQ) { const int kb = r / 24, nb = r % 24; transpose_item(p.in[9], 768, kb * 64, nb * 32, (bf16_t*)(ws + WS_WUQ), 384, 0, nb * 32, (nb % 3) == 2, scr, lane, 0.10206207261596575f * 1.4426950408889634f); continue; }
        r -= I_UQ;
        if (r < I_UKV) { const int kb = r / 32, nb = r % 32, h = nb >> 2, part = nb & 3; const int dr = part < 2 ? h * 64 + part * 32 : 512 + h * 64 + (part - 2) * 32;
            transpose_item(p.in[11], 1024, kb * 64, nb * 32, (bf16_t*)(ws + WS_WUKV), 256, 0, dr, false, scr, lane); continue; }
        r -= I_UKV;
        if (r < I_OUT) { const int kb = r / 32, nb = r % 32; transpose_item(p.in[24], DM, kb * 64, nb * 32, (bf16_t*)(ws + WS_WOUT), DM, 0, nb * 32, false, scr, lane); continue; }
        r -= I_OUT;
        bf16_t* WL = (bf16_t*)(ws + WS_WL);
        if (r < 4 * I_L) { const int which = r / I_L, nb = r % I_L, d = which & 1; const bool isa = which >= 2;
            transpose_item(p.in[isa ? 17 : 15] + (size_t)d * 64 * 512, 512, 0, nb * 32, WL + (isa ? 131072 : 0), 128, d * 64, d * 512 + nb * 32, false, scr, lane); continue; }
        r -= 4 * I_L;
        { const int kb = r / 16, nb = r % 16; transpose_item(p.in[18], 512, kb * 64, nb * 32, WL + 262144, 128, 0, nb * 32, false, scr, lane); }
    }
    if (which == 2) return;
    { bf16_t* WIN = (bf16_t*)(ws + WS_WIN); const u32x4 z = {0u, 0u, 0u, 0u};
      for (int i = gtid; i < 224 * 128; i += GT) { const int rr = i >> 7, c = i & 127; const int row = rr < 96 ? 672 + rr : 2688 + (rr - 96); *(u32x4*)(WIN + (size_t)row * DM + c * 8) = z; } }
    { float* rope = (float*)(ws + WS_ROPE);
      for (int i = gtid; i < 16384 * 16; i += GT) { const int t = i >> 4, k = i & 15; const float ang = (float)t * ROPE_INV[k];
        const double a = (double)ang; const double n = rint(a * 0.15915494309189535); const double rr = a - n * 6.283185307179586; const float rf = (float)rr;
        rope[2 * i] = cosf(rf); rope[2 * i + 1] = sinf(rf); } }
}

__device__ __forceinline__ void norm_row(const float* src, const bf16_t* add, const float* gain, bf16_t* ob, float* of, int lane) {
    f32x4 v[4]; float s = 0.f;
#pragma unroll
    for (int j = 0; j < 4; ++j) { v[j] = *((const f32x4*)src + lane + 64 * j);
        if (add) { const u32x2 d = *((const u32x2*)add + lane + 64 * j); v[j][0] += bflo(d.x); v[j][1] += bfhi(d.x); v[j][2] += bflo(d.y); v[j][3] += bfhi(d.y); }
        s += (v[j][0] * v[j][0] + v[j][1] * v[j][1]) + (v[j][2] * v[j][2] + v[j][3] * v[j][3]); }
    const float rstd = 1.0f / sqrtf(wave_sum(s) * (1.f / DM) + NORM_EPS);
#pragma unroll
    for (int j = 0; j < 4; ++j) { const f32x4 g = *((const f32x4*)gain + lane + 64 * j); const f32x4 o = v[j] * rstd * g;
        if (ob) { u32x2 w; w.x = pkbf(o[0], o[1]); w.y = pkbf(o[2], o[3]); *((u32x2*)ob + lane + 64 * j) = w; }
        else *((f32x4*)of + lane + 64 * j) = o; }
}

__device__ __forceinline__ void norm_row_bf(const bf16_t* src, const float* gain, bf16_t* ob, float* of, int lane) {
    float v[16]; float s = 0.f;
    const u32x4 w0 = *((const u32x4*)src + lane), w1 = *((const u32x4*)src + lane + 64);
    unpack8bf(w0, v); unpack8bf(w1, v + 8);
#pragma unroll
    for (int e = 0; e < 16; ++e) s += v[e] * v[e];
    const float rstd = 1.0f / sqrtf(wave_sum(s) * (1.f / DM) + NORM_EPS);
#pragma unroll
    for (int h = 0; h < 2; ++h) { const float* g = gain + h * 512 + lane * 8; const f32x4 g0 = *(const f32x4*)g, g1 = *(const f32x4*)(g + 4);
        float o[8];
#pragma unroll
        for (int e = 0; e < 4; ++e) { o[e] = v[h * 8 + e] * rstd * g0[e]; o[4 + e] = v[h * 8 + 4 + e] * rstd * g1[e]; }
        if (ob) { u32x4 w; w.x = pkbf(o[0], o[1]); w.y = pkbf(o[2], o[3]); w.z = pkbf(o[4], o[5]); w.w = pkbf(o[6], o[7]); *((u32x4*)ob + lane + 64 * h) = w; }
        else { const f32x4 a = {o[0], o[1], o[2], o[3]}, b = {o[4], o[5], o[6], o[7]}; *(f32x4*)(of + h * 512 + lane * 8) = a; *(f32x4*)(of + h * 512 + lane * 8 + 4) = b; } }
}

__device__ __forceinline__ void p5_row(const P& p, int row, int lane) {
    unsigned char* ws = p.ws;
    bf16_t* za = (bf16_t*)(ws + WS_ZA) + (size_t)row * 768;
    { unsigned* q = (unsigned*)(za + lane * 6); const unsigned w0 = q[0], w1 = q[1], w2 = q[2];
      float f[6] = {bflo(w0), bfhi(w0), bflo(w1), bfhi(w1), bflo(w2), bfhi(w2)}; float s = 0.f;
#pragma unroll
      for (int e = 0; e < 6; ++e) s += f[e] * f[e];
      const float rstd = 1.0f / sqrtf(wave_sum(s) * (1.f / 384.f) + NORM_EPS); const float* g = p.in[8] + lane * 6;
#pragma unroll
      for (int e = 0; e < 6; ++e) f[e] = f[e] * rstd * g[e];
      q[0] = pkbf(f[0], f[1]); q[1] = pkbf(f[2], f[3]); q[2] = pkbf(f[4], f[5]); }
    { unsigned* q = (unsigned*)(za + 384 + lane * 4); const unsigned w0 = q[0], w1 = q[1];
      float f[4] = {bflo(w0), bfhi(w0), bflo(w1), bfhi(w1)}; float s = 0.f;
#pragma unroll
      for (int e = 0; e < 4; ++e) s += f[e] * f[e];
      const float rstd = 1.0f / sqrtf(wave_sum(s) * (1.f / 256.f) + NORM_EPS); const float* g = p.in[10] + lane * 4;
#pragma unroll
      for (int e = 0; e < 4; ++e) f[e] = f[e] * rstd * g[e];
      q[0] = pkbf(f[0], f[1]); q[1] = pkbf(f[2], f[3]); }
    if (lane < 16) { const float x1 = __uint_as_float((unsigned)za[640 + lane] << 16), x2 = __uint_as_float((unsigned)za[656 + lane] << 16);
      const float* rp = (const float*)(ws + WS_ROPE) + ((size_t)seq_pos(row) * 16 + lane) * 2; const float c = rp[0], s = rp[1];
      const unsigned w = pkbf(x1 * c - x2 * s, x1 * s + x2 * c);
      unsigned* kr = (unsigned*)((bf16_t*)((unsigned char*)p.out + DO_K) + (size_t)row * 768 + 64) + lane;
#pragma unroll
      for (int h = 0; h < NH; ++h) kr[h * 48] = w; }
    { const int pos = seq_pos(row), L = row < TP ? 8192 : 16384;
      const bf16_t* zl = (const bf16_t*)(ws + WS_ZL) + (size_t)row * 512 + lane * 6;
      const unsigned* q = (const unsigned*)zl; const unsigned w0 = q[0], w1 = q[1], w2 = q[2];
      unsigned p0 = 0, p1 = 0, p2 = 0, n0 = 0, n1 = 0, n2 = 0;
      if (pos > 0) { const unsigned* qq = (const unsigned*)(zl - 512); p0 = qq[0]; p1 = qq[1]; p2 = qq[2]; }
      if (pos < L - 1) { const unsigned* qq = (const unsigned*)(zl + 512); n0 = qq[0]; n1 = qq[1]; n2 = qq[2]; }
      const float z[6] = {bflo(w0), bfhi(w0), bflo(w1), bfhi(w1), bflo(w2), bfhi(w2)};
      const float zp[6] = {bflo(p0), bfhi(p0), bflo(p1), bfhi(p1), bflo(p2), bfhi(p2)};
      const float zn[6] = {bflo(n0), bfhi(n0), bflo(n1), bfhi(n1), bflo(n2), bfhi(n2)};
      const float* mu0 = p.in[13] + 1536 + lane * 6; const float* mu1 = p.in[13] + 1920 + 1536 + lane * 6;
      float o[6];
#pragma unroll
      for (int e = 0; e < 6; ++e) { const int c = lane * 6 + e; const float zs = z[e] + mu0[e] * (zp[e] - z[e]) + mu1[e] * (zn[e] - z[e]);
        float r;
        if (c < 128) { const float t = __expf(2.f * zs); r = 1.f - 2.f * __builtin_amdgcn_rcpf(t + 1.f); }
        else if (c < 256) r = zs;
        else r = fsigmoid(zs);
        o[e] = r; }
      unsigned* lo = (unsigned*)((bf16_t*)(ws + WS_LIN) + (size_t)row * 384 + lane * 6);
      lo[0] = pkbf(o[0], o[1]); lo[1] = pkbf(o[2], o[3]); lo[2] = pkbf(o[4], o[5]); }
}

__device__ __forceinline__ void shift8(const bf16_t* base, int pitch, bool hasp, bool hasn, const float* mu0, const float* mu1, float* o) {
    const u32x4 w = *(const u32x4*)base; u32x4 wp = {0u, 0u, 0u, 0u}, wn = {0u, 0u, 0u, 0u};
    if (hasp) wp = *(const u32x4*)(base - pitch);
    if (hasn) wn = *(const u32x4*)(base + pitch);
    float z[8], zp[8], zn[8]; unpack8bf(w, z); unpack8bf(wp, zp); unpack8bf(wn, zn);
#pragma unroll
    for (int e = 0; e < 8; ++e) o[e] = z[e] + mu0[e] * (zp[e] - z[e]) + mu1[e] * (zn[e] - z[e]);
}
__device__ __forceinline__ float sum8(float v) { v += __shfl_xor(v, 1); v += __shfl_xor(v, 2); v += __shfl_xor(v, 4); return v; }
__device__ __forceinline__ void p10_att_row(const P& p, int row, int lane) {
    unsigned char* ws = p.ws;
    bf16_t* mix = (bf16_t*)(ws + WS_MIX) + (size_t)row * 1024;
    { u32x4* q = (u32x4*)(mix + lane * 8); const u32x4 w = *q; float f[8]; unpack8bf(w, f); float s = 0.f;
#pragma unroll
      for (int e = 0; e < 8; ++e) s += f[e] * f[e];
      const float rstd = 1.0f / sqrtf(wave_sum(s) * (1.f / 512.f) + NORM_EPS); const float* g = p.in[12] + lane * 8;
#pragma unroll
      for (int e = 0; e < 8; ++e) f[e] = f[e] * rstd * g[e];
      u32x4 o; o.x = pkbf(f[0], f[1]); o.y = pkbf(f[2], f[3]); o.z = pkbf(f[4], f[5]); o.w = pkbf(f[6], f[7]); *q = o; }
}
__device__ __forceinline__ void p10_row(const P& p, int row, int lane) {
    unsigned char* ws = p.ws;
    bf16_t* mix = (bf16_t*)(ws + WS_MIX) + (size_t)row * 1024;
    { const int c = lane * 8; const int pos = seq_pos(row), L = row < TP ? 8192 : 16384; const bool hasp = pos > 0, hasn = pos < L - 1;
      const float* mu = p.in[13];
      const bf16_t* zr = (const bf16_t*)(ws + WS_ZRKV) + (size_t)row * 1536 + c;
      float v[8];
      shift8(zr + 1024, 1536, hasp, hasn, mu + 1024 + c, mu + 1920 + 1024 + c, v);
      float g[8]; unpack8bf(*(const u32x4*)(mix + 512 + c), g);
      const bf16_t* yp = (const bf16_t*)(ws + WS_Y) + (size_t)row * 512 + c;
      float y[8], yb2[8]; unpack8bf(*(const u32x4*)yp, y); unpack8bf(*(const u32x4*)(yp + (size_t)T * 512), yb2);
#pragma unroll
      for (int e = 0; e < 8; ++e) y[e] += yb2[e];
      float s = 0.f;
#pragma unroll
      for (int e = 0; e < 8; ++e) s += y[e];
      const float mean = sum8(s) * (1.f / 64.f); float q = 0.f;
#pragma unroll
      for (int e = 0; e < 8; ++e) { y[e] -= mean; q += y[e] * y[e]; }
      const float rstd = 1.0f / sqrtf(sum8(q) * (1.f / 64.f) + LNX_EPS);
      const float* lw = p.in[22] + c; const float* lb = p.in[23] + c;
      const float* bsp = (const float*)(ws + WS_BS) + (size_t)row * 8 + (lane >> 3);
      const float bs = bsp[0] + bsp[(size_t)T * 8];
      float o[8];
#pragma unroll
      for (int e = 0; e < 8; ++e) o[e] = (y[e] * rstd * lw[e] + lb[e] + bs * v[e]) * g[e];
      u32x4 w; w.x = pkbf(o[0], o[1]); w.y = pkbf(o[2], o[3]); w.z = pkbf(o[4], o[5]); w.w = pkbf(o[6], o[7]);
      *(u32x4*)(mix + 512 + c) = w; }
}

namespace att {
using bf16x8 = __attribute__((ext_vector_type(8))) short;
using s16x4  = __attribute__((ext_vector_type(4))) short;
using f32x16 = __attribute__((ext_vector_type(16))) float;
constexpr int NW = 8, QBLK = 32, KVBLK = 64, LDQ = 768, LDK = 768, LDV = 512, LDO = 1024;
constexpr float SCALE = 0.10206207261596575f, THR = 8.f;
constexpr int SHM_V = 16384, SHM_K = 16384, NBUF = 3, SHM_ATTN = NBUF * SHM_V + NBUF * SHM_K + NW * 64 * 4;
#define KSWZ(row, colB) ((row) * 256 + ((colB) ^ (((row) & 7) << 4)))
#define SBAR() __builtin_amdgcn_sched_barrier(0)
__device__ __forceinline__ int crow(int r, int hi) { return (r & 3) + 8 * (r >> 2) + 4 * hi; }
__device__ __forceinline__ unsigned cvtpk(float lo, float hi) { unsigned r; asm volatile("v_cvt_pk_bf16_f32 %0, %1, %2" : "=v"(r) : "v"(lo), "v"(hi)); return r; }
constexpr float THRL = 11.5415603f;
template <bool FIRST>
__device__ __forceinline__ void partialSM(f32x16& p0, f32x16& p1, float& m_reg, float& alpha) {
  float a = fmaxf(fmaxf(p0[0], p0[1]), p0[2]), b = fmaxf(fmaxf(p1[0], p1[1]), p1[2]);
#pragma unroll
  for (int r = 3; r < 15; r += 2) { a = fmaxf(fmaxf(a, p0[r]), p0[r + 1]); b = fmaxf(fmaxf(b, p1[r]), p1[r + 1]); }
  float pmax = fmaxf(fmaxf(a, b), fmaxf(p0[15], p1[15]));
  { auto rr = __builtin_amdgcn_permlane32_swap(__float_as_uint(pmax), __float_as_uint(pmax), false, false);
    pmax = fmaxf(__uint_as_float(rr[0]), __uint_as_float(rr[1])); }
  alpha = 1.f;
  if (FIRST || !__builtin_expect(__all(pmax <= THRL), 1)) {
    const float dl = FIRST ? pmax : fmaxf(pmax, 0.f);
    m_reg += dl; if (!FIRST) alpha = __builtin_amdgcn_exp2f(-dl);
#pragma unroll
    for (int r = 0; r < 16; ++r) { p0[r] -= dl; p1[r] -= dl; }
  }
#pragma unroll
  for (int r = 0; r < 16; ++r) p0[r] = __builtin_amdgcn_exp2f(p0[r]);
}
__device__ __forceinline__ void finishSM(f32x16& p0, f32x16& p1, float alpha, float& l_reg, bf16x8& pa0, bf16x8& pa1, bf16x8& pa2, bf16x8& pa3) {
#pragma unroll
  for (int r = 0; r < 16; ++r) p1[r] = __builtin_amdgcn_exp2f(p1[r]);
  typedef float f2_t __attribute__((ext_vector_type(2)));
  f2_t s2a = {p0[0], p0[1]}, s2b = {p1[0], p1[1]};
#pragma unroll
  for (int r = 2; r < 16; r += 2) { s2a += (f2_t){p0[r], p0[r + 1]}; s2b += (f2_t){p1[r], p1[r + 1]}; }
  s2a += s2b; float ps = s2a.x + s2a.y;
  { auto rr = __builtin_amdgcn_permlane32_swap(__float_as_uint(ps), __float_as_uint(ps), false, false);
    ps = __uint_as_float(rr[0]) + __uint_as_float(rr[1]); }
  l_reg = l_reg * alpha + ps;
#define PK4(PP, BASE, OUT) do { unsigned a0 = cvtpk(PP[BASE + 0], PP[BASE + 1]), a1 = cvtpk(PP[BASE + 2], PP[BASE + 3]);   \
    unsigned b0 = cvtpk(PP[BASE + 4], PP[BASE + 5]), b1 = cvtpk(PP[BASE + 6], PP[BASE + 7]);                              \
    auto r0 = __builtin_amdgcn_permlane32_swap(a0, b0, false, false); auto r1 = __builtin_amdgcn_permlane32_swap(a1, b1, false, false); \
    u32x4 w = {r0[0], r1[0], r0[1], r1[1]}; OUT = *reinterpret_cast<bf16x8*>(&w); } while (0)
  PK4(p0, 0, pa0); PK4(p0, 8, pa1); PK4(p1, 0, pa2); PK4(p1, 8, pa3);
#undef PK4
}
__device__ __forceinline__ void qkt(f32x16& p0, f32x16& p1, const char* Ks, const bf16x8* qr, int r32, int hi, float m_reg) {
#pragma unroll
  for (int r = 0; r < 16; ++r) { p0[r] = -m_reg; p1[r] = -m_reg; }
#pragma unroll
  for (int d0 = 0; d0 < 6; ++d0) { int cb = (d0 * 16 + hi * 8) * 2;
    bf16x8 b0 = *reinterpret_cast<const bf16x8*>(Ks + KSWZ(r32, cb));
    bf16x8 b1 = *reinterpret_cast<const bf16x8*>(Ks + KSWZ(32 + r32, cb));
    p0 = __builtin_amdgcn_mfma_f32_32x32x16_bf16(b0, qr[d0], p0, 0, 0, 0);
    p1 = __builtin_amdgcn_mfma_f32_32x32x16_bf16(b1, qr[d0], p1, 0, 0, 0); }
}
__device__ __forceinline__ int v_st(int k, int c) { const int kk = (k & ~0xC) | ((k & 4) << 1) | ((k & 8) >> 1); return ((kk >> 3) * 4 + (c >> 5)) * 512 + ((kk & 7) * 32 + (c & 31)) * 2; }
__device__ __forceinline__ int v_rd_base(int lane) { return ((lane & 3) << 3) | (((lane >> 2) & 3) << 6) | (((lane >> 4) & 1) << 5) | (((lane >> 5) & 1) << 8); }
constexpr int v_rd_off(int d0, int ks, int half) { return d0 * 512 + ks * 4096 + half * 2048; }
template <int OFF> __device__ __forceinline__ s16x4 tr_read(int vb) {
  s16x4 r; asm volatile("ds_read_b64_tr_b16 %0, %1 offset:%2" : "=&v"(r) : "v"(vb), "i"(OFF) : "memory"); return r;
}
template <int D0> __device__ __forceinline__ void pv_one(f32x16& od, int vb, bf16x8 pa0, bf16x8 pa1, bf16x8 pa2, bf16x8 pa3) {
  const s16x4 l0 = tr_read<v_rd_off(D0, 0, 0)>(vb), h0 = tr_read<v_rd_off(D0, 0, 1)>(vb), l1 = tr_read<v_rd_off(D0, 1, 0)>(vb), h1 = tr_read<v_rd_off(D0, 1, 1)>(vb);
  const s16x4 l2 = tr_read<v_rd_off(D0, 2, 0)>(vb), h2 = tr_read<v_rd_off(D0, 2, 1)>(vb), l3 = tr_read<v_rd_off(D0, 3, 0)>(vb), h3 = tr_read<v_rd_off(D0, 3, 1)>(vb);
  asm volatile("s_waitcnt lgkmcnt(0)" ::: "memory"); SBAR();
#define PKV(L, H) (bf16x8){L[0], L[1], L[2], L[3], H[0], H[1], H[2], H[3]}
  od = __builtin_amdgcn_mfma_f32_32x32x16_bf16(pa0, PKV(l0, h0), od, 0, 0, 0);
  od = __builtin_amdgcn_mfma_f32_32x32x16_bf16(pa1, PKV(l1, h1), od, 0, 0, 0);
  od = __builtin_amdgcn_mfma_f32_32x32x16_bf16(pa2, PKV(l2, h2), od, 0, 0, 0);
  od = __builtin_amdgcn_mfma_f32_32x32x16_bf16(pa3, PKV(l3, h3), od, 0, 0, 0);
#undef PKV
}
__device__ __forceinline__ void pv_d0(f32x16* o, int vb, bf16x8 pa0, bf16x8 pa1, bf16x8 pa2, bf16x8 pa3) {
  pv_one<0>(o[0], vb, pa0, pa1, pa2, pa3); pv_one<1>(o[1], vb, pa0, pa1, pa2, pa3);
}
__device__ __forceinline__ void attn_unit(const bf16_t* __restrict__ Qb, const bf16_t* __restrict__ Kh, const bf16_t* __restrict__ Vh, bf16_t* __restrict__ Ob, int seq, char* lds, const float* rope, int qpos0) {
  int tid_ = threadIdx.x; asm volatile("" : "+v"(tid_));
  const int tid = tid_, wid = tid >> 6, lane = tid & 63, r32 = lane & 31, hi = lane >> 5;
  char* V_lds = lds; char* K_lds = lds + NBUF * SHM_V;
  float* ws = (float*)(lds + NBUF * SHM_V + NBUF * SHM_K) + wid * 64; float* li_l = ws; float* al_l = ws + 32;
  float m_reg = 0.f, l_reg = 0; f32x16 o[2] = {}; bf16x8 qr[6];
  const bf16_t* Qw = Qb + (long)(wid * QBLK + r32) * LDQ + hi * 8;
#pragma unroll
  for (int d0 = 0; d0 < 6; ++d0) qr[d0] = *reinterpret_cast<const bf16x8*>(Qw + d0 * 16);
#pragma unroll
  for (int d0 = 4; d0 < 6; ++d0) {
    const float* rp = rope + ((size_t)(qpos0 + wid * QBLK + r32) * 16 + (d0 - 4) * 8 + hi * 4) * 2;
    const f32x4 t0 = *(const f32x4*)rp, t1 = *(const f32x4*)(rp + 4);
    float f[8]; unpack8bf(*reinterpret_cast<const u32x4*>(&qr[d0]), f);
    u32x4 w;
    w.x = cvtpk(f[0] * t0[0] - f[1] * t0[1], f[0] * t0[1] + f[1] * t0[0]);
    w.y = cvtpk(f[2] * t0[2] - f[3] * t0[3], f[2] * t0[3] + f[3] * t0[2]);
    w.z = cvtpk(f[4] * t1[0] - f[5] * t1[1], f[4] * t1[1] + f[5] * t1[0]);
    w.w = cvtpk(f[6] * t1[2] - f[7] * t1[3], f[6] * t1[3] + f[7] * t1[2]);
    qr[d0] = *reinterpret_cast<bf16x8*>(&w);
  }
  const int kr0 = tid / 12, kc0 = (tid % 12) * 8, kr1 = (512 + tid) / 12, kc1 = ((512 + tid) % 12) * 8; const bool k2 = __builtin_amdgcn_readfirstlane(tid) < 256;
  const int vr = tid >> 3, vc = (tid & 7) * 8, vst = v_st(vr, vc);
  const int kst0 = KSWZ(kr0, kc0 * 2), kst1 = KSWZ(kr1, kc1 * 2);
  const int vb0 = (int)(uintptr_t)V_lds + v_rd_base(lane);
  struct { bf16x8 vs, ks0, ks1; } sr_;
  const unsigned vo_ = (unsigned)(vr * LDV + vc) * 2u, ko0_ = (unsigned)(kr0 * LDK + kc0) * 2u, ko1_ = (unsigned)(kr1 * LDK + kc1) * 2u;
#define SLOAD(k0) do { const unsigned kt_ = (unsigned)(k0) * (LDK * 2u), vt_ = (unsigned)(k0) * (LDV * 2u); \
    sr_.vs = *reinterpret_cast<const bf16x8*>((const char*)Vh + (vo_ + vt_)); \
    sr_.ks0 = *reinterpret_cast<const bf16x8*>((const char*)Kh + (ko0_ + kt_)); \
    if (k2) sr_.ks1 = *reinterpret_cast<const bf16x8*>((const char*)Kh + (ko1_ + kt_)); } while (0)
#define SWRITE(bo) do { *(bf16x8*)(V_lds + (bo) + vst) = sr_.vs; *(bf16x8*)(K_lds + (bo) + kst0) = sr_.ks0; \
    if (k2) *(bf16x8*)(K_lds + (bo) + kst1) = sr_.ks1; } while (0)
#define RESC(a) do { if (__any((a) < 1.f)) { if (hi == 0) al_l[r32] = (a); asm volatile("s_waitcnt lgkmcnt(0)" ::: "memory"); \
    _Pragma("unroll") for (int d = 0; d < 2; ++d) _Pragma("unroll") for (int r = 0; r < 16; ++r) o[d][r] *= al_l[crow(r, hi)]; } } while (0)
#define ROT3() do { const int t_ = bp; bp = bc; bc = bn; bn = t_; } while (0)
  static_assert(SHM_V == SHM_K, "one ring offset serves both");
  f32x16 pA0, pA1, pB0, pB1; float alA, alB; bf16x8 pa0, pa1, pa2, pa3; const int NT = seq / KVBLK;
  int bp = 0, bc = SHM_K, bn = 2 * SHM_K;
  if (__builtin_amdgcn_readfirstlane(tid) >= 256) __builtin_amdgcn_s_setprio(1);
  SLOAD(0); SWRITE(0); SLOAD(KVBLK); __syncthreads();
  qkt(pA0, pA1, K_lds, qr, r32, hi, m_reg); partialSM<true>(pA0, pA1, m_reg, alA);
  SWRITE(SHM_K); SLOAD(2 * KVBLK); __syncthreads();
  for (int j = 1; j + 1 < NT; j += 2) {
    SBAR(); qkt(pB0, pB1, K_lds + bc, qr, r32, hi, m_reg);
    finishSM(pA0, pA1, alA, l_reg, pa0, pa1, pa2, pa3); SBAR();
    pv_d0(o, vb0 + bp, pa0, pa1, pa2, pa3); partialSM<false>(pB0, pB1, m_reg, alB);
    SWRITE(bn); SLOAD((j + 2) * KVBLK);
    RESC(alB); __syncthreads(); ROT3();
    SBAR(); qkt(pA0, pA1, K_lds + bc, qr, r32, hi, m_reg);
    finishSM(pB0, pB1, alB, l_reg, pa0, pa1, pa2, pa3); SBAR();
    pv_d0(o, vb0 + bp, pa0, pa1, pa2, pa3); partialSM<false>(pA0, pA1, m_reg, alA);
    SWRITE(bn); if (j + 3 < NT) SLOAD((j + 3) * KVBLK);
    RESC(alA); __syncthreads(); ROT3();
  }
  SBAR(); qkt(pB0, pB1, K_lds + bc, qr, r32, hi, m_reg);
  finishSM(pA0, pA1, alA, l_reg, pa0, pa1, pa2, pa3); SBAR();
  pv_d0(o, vb0 + bp, pa0, pa1, pa2, pa3); partialSM<false>(pB0, pB1, m_reg, alB);
  RESC(alB);
  finishSM(pB0, pB1, alB, l_reg, pa0, pa1, pa2, pa3); SBAR();
  pv_d0(o, vb0 + bc, pa0, pa1, pa2, pa3);
#undef ROT3
  if (hi == 0) li_l[r32] = l_reg; asm volatile("s_waitcnt lgkmcnt(0)" ::: "memory");
  float rli[16];
#pragma unroll
  for (int r = 0; r < 16; ++r) rli[r] = __builtin_amdgcn_rcpf(li_l[crow(r, hi)]);
  bf16_t* Ow = Ob + (long)(wid * QBLK) * LDO;
#pragma unroll
  for (int r = 0; r < 16; ++r) { int orow = crow(r, hi);
#pragma unroll
    for (int d0 = 0; d0 < 2; ++d0) { const float val = o[d0][r] * rli[r]; Ow[(long)orow * LDO + d0 * 32 + r32] = (bf16_t)(cvtpk(val, val) & 0xffffu); } }
  __builtin_amdgcn_s_setprio(0);
  __syncthreads();
#undef SLOAD
#undef SWRITE
#undef RESC
}
#undef KSWZ
#undef SBAR
}

typedef float f32x2 __attribute__((ext_vector_type(2)));
template <int CTRL> __device__ __forceinline__ float dppx(float v) { return __int_as_float(__builtin_amdgcn_update_dpp(0, __float_as_int(v), CTRL, 0xF, 0xF, true)); }
__device__ __forceinline__ float reduce16(float v) { v += dppx<0xB1>(v); v += dppx<0x4E>(v); v += dppx<0x141>(v); v += dppx<0x140>(v); return v; }
struct ScanRaw { u32x4 r[3], k[3], v[3], w, a; };
__device__ __forceinline__ void scan_load(ScanRaw& R, const bf16_t* zr, const unsigned short* wa, bool hasp, bool hasn) {
    const u32x4 z = {0u, 0u, 0u, 0u};
    R.r[1] = *(const u32x4*)zr; R.k[1] = *(const u32x4*)(zr + 512); R.v[1] = *(const u32x4*)(zr + 1024);
    R.r[0] = z; R.k[0] = z; R.v[0] = z; R.r[2] = z; R.k[2] = z; R.v[2] = z;
    if (hasp) { R.r[0] = *(const u32x4*)(zr - 1536); R.k[0] = *(const u32x4*)(zr - 1536 + 512); R.v[0] = *(const u32x4*)(zr - 1536 + 1024); }
    if (hasn) { R.r[2] = *(const u32x4*)(zr + 1536); R.k[2] = *(const u32x4*)(zr + 1536 + 512); R.v[2] = *(const u32x4*)(zr + 1536 + 1024); }
    R.w = *(const u32x4*)wa; R.a = *(const u32x4*)(wa + 1024);
}
__device__ __forceinline__ void shift8r(const u32x4 wp, const u32x4 w, const u32x4 wn, const float* mu0, const float* mu1, float* o) {
    float z[8], zp[8], zn[8]; unpack8bf(w, z); unpack8bf(wp, zp); unpack8bf(wn, zn);
#pragma unroll
    for (int e = 0; e < 8; ++e) o[e] = z[e] + mu0[e] * (zp[e] - z[e]) + mu1[e] * (zn[e] - z[e]);
}
template <int RPL, int NSW>
__device__ __forceinline__ void scan_item(const P& p, LAS unsigned char* lds, int seqbase, int L, int head, int dir, int part, int step0, int nsteps, int mode, float* qc, float* smid) {
    constexpr int WR = NSW * 4 * RPL, TC = 32, ARR = TC * 64;
    constexpr int BUF_FLOATS = 5 * ARR + 5 * TC * WR;
    static_assert(WR == 32, "flush mapping assumes 32 rows per workgroup");
    static_assert(2 * BUF_FLOATS * 4 <= 131072, "scan LDS");
    LAS float* lf = (LAS float*)lds;
    int tid_ = threadIdx.x; asm volatile("" : "+v"(tid_));
    const int tid = tid_, wave = __builtin_amdgcn_readfirstlane(tid >> 6), lane = tid & 63;
    const int rowbase = part * WR, NC = nsteps / TC;
    unsigned char* ws = p.ws;
    const bf16_t* ZR = (const bf16_t*)(ws + WS_ZRKV);
    const unsigned short* WA = (const unsigned short*)((unsigned char*)p.out + DO_WA);
    bf16_t* Yd = (bf16_t*)(ws + WS_Y) + (dir ? (size_t)T * 512 : 0);
    const bool is_scan = wave < NSW;
    const bool is_prod = (NSW == 4) ? (wave >= 4) : ((wave & 2) != 0);
    if (is_prod) {
        const int pw = (NSW == 4) ? (wave - 4) : (((wave >> 2) << 1) | (wave & 1));
        const int ptid = pw * 64 + lane, s = ptid >> 3, d0 = (ptid & 7) * 8, c = head * 64 + d0;
        float mu[6][8], kk_k[8], k_a[8], r_kk[8];
#pragma unroll
        for (int e = 0; e < 8; ++e) { mu[0][e] = p.in[13][c + e]; mu[1][e] = p.in[13][1920 + c + e]; mu[2][e] = p.in[13][512 + c + e]; mu[3][e] = p.in[13][1920 + 512 + c + e];
            mu[4][e] = p.in[13][1024 + c + e]; mu[5][e] = p.in[13][1920 + 1024 + c + e]; kk_k[e] = p.in[19][c + e]; k_a[e] = p.in[20][c + e]; r_kk[e] = p.in[21][c + e]; }
        float* BSd = (float*)(ws + WS_BS) + (size_t)dir * T * 8;
#define SCAN_FLUSH() do { const int r0_ = (ptid & 7) * 4; float o_[4]; \
            _Pragma("unroll") for (int i_ = 0; i_ < 4; ++i_) { const f32x4 pv_ = *(LAS const f32x4*)(yb + (s * WR + r0_ + i_) * 4); o_[i_] = (pv_[0] + pv_[1]) + (pv_[2] + pv_[3]); } \
            if (mode == 0) { u32x2 w_; w_.x = pkbf(o_[0], o_[1]); w_.y = pkbf(o_[2], o_[3]); *(u32x2*)(Yd + (size_t)(seqbase + t) * 512 + head * 64 + rowbase + r0_) = w_; } \
            else { const f32x4 q_ = {o_[0], o_[1], o_[2], o_[3]}; *(f32x4*)(qc + (size_t)(step - step0) * 64 + rowbase + r0_) = q_; } } while (0)
        ScanRaw cur, nxt;
        { const int t = dir ? (L - 1 - (step0 + s)) : (step0 + s); scan_load(cur, ZR + (size_t)(seqbase + t) * 1536 + c, WA + (size_t)(seqbase + t) * 2048 + dir * 512 + c, t > 0, t < L - 1); }
        nxt = cur;
        for (int ch = 0; ch <= NC; ++ch) {
            if (ch + 1 < NC) { const int step = step0 + (ch + 1) * TC + s; const int t = dir ? (L - 1 - step) : step;
                scan_load(nxt, ZR + (size_t)(seqbase + t) * 1536 + c, WA + (size_t)(seqbase + t) * 2048 + dir * 512 + c, t > 0, t < L - 1); }
            if (ch >= 2) { const int fc = ch - 2; LAS const float* yb = lf + (fc & 1) * BUF_FLOATS + 5 * ARR + TC * WR;
                const int step = step0 + fc * TC + s; const int t = dir ? (L - 1 - step) : step;
                SCAN_FLUSH(); }
            if (ch < NC) {
                LAS float* b = lf + (ch & 1) * BUF_FLOATS;
                float r[8], k[8], v[8], w[8], a[8];
                shift8r(cur.r[0], cur.r[1], cur.r[2], mu[0], mu[1], r);
                shift8r(cur.k[0], cur.k[1], cur.k[2], mu[2], mu[3], k);
                shift8r(cur.v[0], cur.v[1], cur.v[2], mu[4], mu[5], v);
                unpack8h(cur.w, w); unpack8h(cur.a, a);
                float kk[8], ss = 0.f;
#pragma unroll
                for (int e = 0; e < 8; ++e) { kk[e] = k[e] * kk_k[e]; ss += kk[e] * kk[e]; }
                ss = sum8(ss);
                const float inv = 1.0f / fmaxf(sqrtf(ss), 1e-12f);
                if (mode == 0 && part == 0) {
                    float bsum = 0.f;
#pragma unroll
                    for (int e = 0; e < 8; ++e) bsum += r[e] * (k[e] * (1.f + (a[e] - 1.f) * k_a[e])) * r_kk[e];
                    bsum = sum8(bsum);
                    const int stepb = step0 + ch * TC + s; const int tb = dir ? (L - 1 - stepb) : stepb;
                    if ((ptid & 7) == 0) BSd[(size_t)(seqbase + tb) * 8 + head] = bsum;
                }
                f32x4 o0, o1;
                LAS float* dst = b + s * 64 + d0;
#pragma unroll
                for (int e = 0; e < 4; ++e) { o0[e] = w[e]; o1[e] = w[4 + e]; }
                *(LAS f32x4*)(dst) = o0; *(LAS f32x4*)(dst + 4) = o1;
#pragma unroll
                for (int e = 0; e < 4; ++e) { o0[e] = k[e] * (1.f + (a[e] - 1.f) * k_a[e]); o1[e] = k[4 + e] * (1.f + (a[4 + e] - 1.f) * k_a[4 + e]); }
                *(LAS f32x4*)(dst + ARR) = o0; *(LAS f32x4*)(dst + ARR + 4) = o1;
#pragma unroll
                for (int e = 0; e < 4; ++e) { o0[e] = kk[e] * inv; o1[e] = kk[4 + e] * inv; }
                *(LAS f32x4*)(dst + 2 * ARR) = o0; *(LAS f32x4*)(dst + 2 * ARR + 4) = o1;
#pragma unroll
                for (int e = 0; e < 4; ++e) { o0[e] = kk[e] * inv * a[e]; o1[e] = kk[4 + e] * inv * a[4 + e]; }
                *(LAS f32x4*)(dst + 3 * ARR) = o0; *(LAS f32x4*)(dst + 3 * ARR + 4) = o1;
#pragma unroll
                for (int e = 0; e < 4; ++e) { o0[e] = r[e]; o1[e] = r[4 + e]; }
                *(LAS f32x4*)(dst + 4 * ARR) = o0; *(LAS f32x4*)(dst + 4 * ARR + 4) = o1;
                if (d0 >= rowbase && d0 < rowbase + WR) {
#pragma unroll
                    for (int e = 0; e < 8; ++e) b[5 * ARR + s * WR + (d0 - rowbase) + e] = mode ? 0.f : v[e]; }
            }
            cur = nxt;
            __syncthreads();
        }
        { const int fc = NC - 1; LAS const float* yb = lf + (fc & 1) * BUF_FLOATS + 5 * ARR + TC * WR;
          const int step = step0 + fc * TC + s; const int t = dir ? (L - 1 - step) : step;
          SCAN_FLUSH(); }
#undef SCAN_FLUSH
    } else if (is_scan) {
        const int i = lane >> 4, kq = lane & 15, lr0 = wave * (4 * RPL) + i * RPL;
        LAS float* ydummy = lf + 2 * BUF_FLOATS + wave * 80 + lane;
        static_assert((2 * BUF_FLOATS + 4 * 80) * 4 <= 131072, "scan LDS incl. dummy slots");
        f32x2 S[RPL][2];
#pragma unroll
        for (int q = 0; q < RPL; ++q) { const int gk = rowbase + lr0 + q - 4 * kq;
            S[q][0] = (f32x2){(mode && gk == 0) ? 1.f : 0.f, (mode && gk == 1) ? 1.f : 0.f}; S[q][1] = (f32x2){(mode && gk == 2) ? 1.f : 0.f, (mode && gk == 3) ? 1.f : 0.f}; }
        __syncthreads();
        for (int ch = 0; ch < NC; ++ch) {
            LAS const float* b = lf + (ch & 1) * BUF_FLOATS; LAS float* yb = lf + (ch & 1) * BUF_FLOATS + 5 * ARR + TC * WR;
            f32x4 xw, xkd, xkk, xb, xr; float vrow[RPL];
#define SCAN_LD(ss) do { LAS const float* src_ = b + (ss) * 64 + kq * 4; xw = *(LAS const f32x4*)(src_); xkd = *(LAS const f32x4*)(src_ + ARR); xkk = *(LAS const f32x4*)(src_ + 2 * ARR); \
                xb = *(LAS const f32x4*)(src_ + 3 * ARR); xr = *(LAS const f32x4*)(src_ + 4 * ARR); _Pragma("unroll") for (int q = 0; q < RPL; ++q) vrow[q] = b[5 * ARR + (ss) * WR + lr0 + q]; } while (0)
            SCAN_LD(0);
#pragma unroll 8
            for (int s = 0; s < TC; ++s) {
                const f32x2 w0 = {xw[0], xw[1]}, w1 = {xw[2], xw[3]}, kd0 = {xkd[0], xkd[1]}, kd1 = {xkd[2], xkd[3]}, kk0 = {xkk[0], xkk[1]}, kk1 = {xkk[2], xkk[3]},
                            b0 = {xb[0], xb[1]}, b1 = {xb[2], xb[3]}, r0 = {xr[0], xr[1]}, r1 = {xr[2], xr[3]};
                float vr[RPL];
#pragma unroll
                for (int q = 0; q < RPL; ++q) vr[q] = vrow[q];
                { const int sn = (s + 1 < TC) ? s + 1 : s; SCAN_LD(sn); }
                float sa[RPL];
#pragma unroll
                for (int q = 0; q < RPL; ++q) { const f32x2 t = S[q][0] * kk0 + S[q][1] * kk1; sa[q] = t.x + t.y; }
                if (RPL == 2) {
                    sa[0] += dppx<0xB1>(sa[0]); sa[RPL - 1] += dppx<0xB1>(sa[RPL - 1]); sa[0] += dppx<0x4E>(sa[0]); sa[RPL - 1] += dppx<0x4E>(sa[RPL - 1]);
                    sa[0] += dppx<0x141>(sa[0]); sa[RPL - 1] += dppx<0x141>(sa[RPL - 1]); sa[0] += dppx<0x140>(sa[0]); sa[RPL - 1] += dppx<0x140>(sa[RPL - 1]);
                } else {
#pragma unroll
                    for (int q = 0; q < RPL; ++q) sa[q] = reduce16(sa[q]);
                }
                float ov[RPL];
                if (RPL == 2) {
                    const f32x2 vva = {vr[0], vr[0]}, nsa = {-sa[0], -sa[0]}, vvb = {vr[RPL - 1], vr[RPL - 1]}, nsb = {-sa[RPL - 1], -sa[RPL - 1]};
                    f32x2 a0 = nsa * b0, c0 = nsb * b0, a1 = nsa * b1, c1 = nsb * b1;
                    a0 = vva * kd0 + a0; c0 = vvb * kd0 + c0; a1 = vva * kd1 + a1; c1 = vvb * kd1 + c1;
                    S[0][0] = S[0][0] * w0 + a0; S[RPL - 1][0] = S[RPL - 1][0] * w0 + c0; S[0][1] = S[0][1] * w1 + a1; S[RPL - 1][1] = S[RPL - 1][1] * w1 + c1;
                    f32x2 ua = S[0][0] * r0, ub = S[RPL - 1][0] * r0;
                    ua = S[0][1] * r1 + ua; ub = S[RPL - 1][1] * r1 + ub;
                    ov[0] = ua.x + ua.y; ov[RPL - 1] = ub.x + ub.y;
                } else {
#pragma unroll
                for (int q = 0; q < RPL; ++q) {
                    const f32x2 vv = {vr[q], vr[q]}, ns = {-sa[q], -sa[q]};
                    S[q][0] = S[q][0] * w0 + (vv * kd0 + ns * b0);
                    S[q][1] = S[q][1] * w1 + (vv * kd1 + ns * b1);
                    const f32x2 t = S[q][0] * r0 + S[q][1] * r1; ov[q] = t.x + t.y;
                }
                }
#pragma unroll
                for (int q = 0; q < RPL; ++q) { ov[q] += dppx<0xB1>(ov[q]); ov[q] += dppx<0x4E>(ov[q]); }
                {
                    LAS float* yw = ((kq & 3) == 0) ? (yb + (s * WR + lr0) * 4 + (kq >> 2)) : ydummy;
#pragma unroll
                    for (int q = 0; q < RPL; ++q) yw[q * 4] = ov[q]; }
            }
#undef SCAN_LD
            __syncthreads();
        }
        if (smid) {
#pragma unroll
            for (int q = 0; q < RPL; ++q) { const f32x4 sv = {S[q][0].x, S[q][0].y, S[q][1].x, S[q][1].y}; *(f32x4*)(smid + (size_t)(rowbase + lr0 + q) * 64 + 4 * kq) = sv; } }
    } else {
        for (int ch = 0; ch <= NC; ++ch) __syncthreads();
    }
}

__device__ __forceinline__ void scan_fix_item(const P& p, LAS unsigned char* lds, int hd, int blk) {
    int tid_ = threadIdx.x; asm volatile("" : "+v"(tid_));
    const int tid = tid_, wave = __builtin_amdgcn_readfirstlane(tid >> 6), lane = tid & 63;
    unsigned char* ws = p.ws;
    const float* smid = (const float*)(ws + WS_SMID) + (size_t)hd * 4096;
    const float* qc = (const float*)(ws + (hd < 12 ? WS_QC0 + (size_t)hd * 2 * MiB : WS_QC1 + (size_t)(hd - 12) * 2 * MiB)) + (size_t)blk * 128 * 64;
    bf16_t* Yd = (bf16_t*)(ws + WS_Y) + ((hd & 1) ? (size_t)T * 512 : 0);
    LAS float* lq = (LAS float*)lds;
    for (int i = tid; i < 128 * 16; i += 512) *(LAS f32x4*)(lq + i * 4) = *(const f32x4*)(qc + i * 4);
    f32x4 sm[16];
#pragma unroll
    for (int i = 0; i < 16; ++i) sm[i] = *(const f32x4*)(smid + lane * 64 + i * 4);
    __syncthreads();
    const int head = hd >> 1, dir = hd & 1;
    for (int s = 0; s < 16; ++s) {
        const int j = wave * 16 + s; LAS const float* q = lq + j * 64;
        float a0 = 0.f, a1 = 0.f, a2 = 0.f, a3 = 0.f;
#pragma unroll
        for (int i = 0; i < 16; ++i) { const f32x4 qv = *(LAS const f32x4*)(q + i * 4); a0 = fmaf(sm[i][0], qv[0], a0); a1 = fmaf(sm[i][1], qv[1], a1); a2 = fmaf(sm[i][2], qv[2], a2); a3 = fmaf(sm[i][3], qv[3], a3); }
        const int jj = blk * 128 + j; const int t = dir ? (8191 - jj) : (8192 + jj);
        bf16_t* yg = Yd + (size_t)(TP + t) * 512 + head * 64 + lane;
        const float yv = __uint_as_float((unsigned)*yg << 16) + ((a0 + a1) + (a2 + a3));
        *yg = (bf16_t)(pkbf(yv, yv) & 0xffffu);
    }
    __syncthreads();
}

#define XB_TMO      128
#define XB_XCNT(j)  (256  + 64 * (j))
#define XB_XSUB(j)  (1280 + 64 * (j))
#define XB_XGEN(j)  (2304 + 64 * (j))
#define XB_TOP      3328
#define XB_TOPGEN   3392
#define XCD_BAR_WORDS 3456
#define XB_SPIN_CAP (1u << 18)

__device__ __forceinline__ unsigned xb_ld(unsigned* p)              { return __hip_atomic_load(p, __ATOMIC_RELAXED, __HIP_MEMORY_SCOPE_AGENT); }
__device__ __forceinline__ unsigned xb_add(unsigned* p, unsigned v) { return __hip_atomic_fetch_add(p, v, __ATOMIC_RELAXED, __HIP_MEMORY_SCOPE_AGENT); }
__device__ __forceinline__ unsigned xb_xcc_id() { return (unsigned)__builtin_amdgcn_s_getreg((3 << 11) | 20) & 0xFu; }
#define XB_SPIN(cond, bar) do { unsigned _sp = 0; while (cond) { __builtin_amdgcn_s_sleep(1); \
    if ((++_sp & 255u) == 0u) { if (xb_ld(&(bar)[XB_TMO])) break; if (_sp > XB_SPIN_CAP) { atomicAdd(&(bar)[XB_TMO], 1u); break; } } } } while (0)

struct XcdBarrier {
    unsigned* bar; unsigned x;
    volatile LAS unsigned* st;
};

__device__ __forceinline__ XcdBarrier xcd_barrier_post(unsigned* bar, volatile LAS unsigned* st) {
    XcdBarrier b; b.bar = bar; b.x = xb_xcc_id(); b.st = st;
    if (threadIdx.x == 0) (void)xb_add(&bar[XB_XCNT(b.x)], 1u);
    return b;
}
__device__ __forceinline__ void xcd_barrier_complete(unsigned* bar, unsigned x, unsigned& nloc, unsigned& nx) {
    const unsigned G = gridDim.x * gridDim.y * gridDim.z;
    unsigned sum, cnt, mine, sp = 0u;
    for (;;) {
        sum = 0u; cnt = 0u; mine = 0u;
#pragma unroll
        for (unsigned j = 0; j < 16; ++j) { const unsigned c = xb_ld(&bar[XB_XCNT(j)]); sum += c; cnt += (c > 0u) ? 1u : 0u; mine = (j == x) ? c : mine; }
        if (sum == G) break;
        __builtin_amdgcn_s_sleep(1);
        if ((++sp & 255u) == 0u) { if (xb_ld(&bar[XB_TMO])) break; if (sp > XB_SPIN_CAP) { atomicAdd(&bar[XB_TMO], 1u); break; } }
    }
    nloc = mine > 0u ? mine : 1u; nx = cnt > 0u ? cnt : 1u;
}

__device__ __forceinline__ void xcd_barrier(const XcdBarrier& b) {
    asm volatile("s_waitcnt vmcnt(0)" ::: "memory");
    __syncthreads();
    if (threadIdx.x == 0) {
        unsigned* bar = b.bar;
        __builtin_amdgcn_s_waitcnt(0);
        unsigned nloc = b.st[0], nx = b.st[1];
        if (nloc == 0u) { xcd_barrier_complete(bar, b.x, nloc, nx); b.st[0] = nloc; b.st[1] = nx; }
        const unsigned old = xb_add(&bar[XB_XSUB(b.x)], 1u);
        const unsigned gen = old / nloc;
        if (old + 1u == (gen + 1u) * nloc) {
            __builtin_amdgcn_fence(__ATOMIC_RELEASE, "agent");
            asm volatile("s_waitcnt vmcnt(0)" ::: "memory");
            const unsigned og = xb_add(&bar[XB_TOP], 1u);
            const unsigned tg = og / nx;
            if (og + 1u == (tg + 1u) * nx) xb_add(&bar[XB_TOPGEN], 1u);
            else XB_SPIN(xb_ld(&bar[XB_TOPGEN]) == tg, bar);
            __builtin_amdgcn_fence(__ATOMIC_ACQUIRE, "agent");
            xb_add(&bar[XB_XGEN(b.x)], 1u);
            asm volatile("s_waitcnt vmcnt(0)" ::: "memory");
        } else {
            XB_SPIN(xb_ld(&bar[XB_XGEN(b.x)]) == gen, bar);
            __builtin_amdgcn_fence(__ATOMIC_ACQUIRE, "agent");
            asm volatile("s_waitcnt vmcnt(0)" ::: "memory");
        }
    }
    __syncthreads();
}
#ifndef NREP_ATT
#define NREP_ATT 1
#endif
#ifndef NREP_SCAN
#define NREP_SCAN 1
#endif
#ifndef NREP_G1
#define NREP_G1 1
#endif

#ifdef NO_GEMM
#define GEMM(EPI, EOBJ, AP, BP, NN, KK, LDA) do {} while(0)
#else
#define GEMM(EPI, EOBJ, AP, BP, NN, KK, LDA) do { pg8::Gemm g_{(const bf16_t*)(AP), (const bf16_t*)(BP), T, (NN), (KK), (LDA)}; pg8::StaticOrder S_; S_.init(T, (NN), G, bx); \
    pg8::gemm_phase<EPI, pg8::StaticOrder, true, true>(lds, g_, S_, EOBJ); } while (0)
#endif

__global__ void __launch_bounds__(512, 2) mega_fwd(const Args a) {
    extern __shared__ __attribute__((aligned(16))) unsigned char lds_raw[];
    cg::grid_group grid = cg::this_grid();
    LAS unsigned char* lds = (LAS unsigned char*)lds_raw;
    const Args& p = a;
    unsigned char* ws = a.ws; unsigned char* dout = (unsigned char*)a.out;
    const int tid = threadIdx.x, lane = tid & 63, wave = __builtin_amdgcn_readfirstlane(tid >> 6);
    const int G = gridDim.x, bx = blockIdx.x;
    const int vcu = (G % 8 == 0) ? (bx % 8) * (G / 8) + bx / 8 : bx;
    const int gw = vcu * 8 + wave, NGW = G * 8, gtid = bx * 512 + tid, GT = G * 512;
    bf16_t* XN = (bf16_t*)(ws + WS_U); bf16_t* ACT = (bf16_t*)(ws + WS_ACT); bf16_t* D1 = (bf16_t*)(ws + WS_D1);
    bf16_t* ZA = (bf16_t*)(ws + WS_ZA); bf16_t* ZRKV = (bf16_t*)(ws + WS_ZRKV); bf16_t* ZL = (bf16_t*)(ws + WS_ZL);
    bf16_t* MIX = (bf16_t*)(ws + WS_MIX); bf16_t* LIN = (bf16_t*)(ws + WS_LIN);
    bf16_t* Qb = (bf16_t*)(dout + DO_Q); bf16_t* Kb = (bf16_t*)(dout + DO_K); bf16_t* Vb = (bf16_t*)(dout + DO_V);
    unsigned short* WA = (unsigned short*)(dout + DO_WA); float* H = a.out;
    const float* rope = (const float*)(ws + WS_ROPE);

    volatile LAS unsigned* bst = (volatile LAS unsigned*)(lds + 131072 + 64);
    if (tid < 2) bst[tid] = 0u;
    __syncthreads();
    const XcdBarrier xbar = xcd_barrier_post((unsigned*)(ws + WS_BAR), bst);
#define GSYNC() xcd_barrier(xbar)
    prologue(p, lds, gw, NGW, wave, lane, gtid, GT, G == 256 ? 1 : 0);
    for (int m = gw; m < T; m += NGW) norm_row(xrow(p, m), nullptr, p.in[2], XN + (size_t)m * DM, nullptr, lane);
    if (a.out == nullptr) grid.sync();
    GSYNC();
#ifndef NO_EpiSwiGLU
    for (int rep_ = 0; rep_ < NREP_G1; ++rep_) { EpiSwiGLU E{ACT}; GEMM(EpiSwiGLU, E, XN, ws + WS_WGU1, 2 * DFF, DM, DM); }
#endif
    GSYNC();
#ifndef NO_EpiScaleBf16
    { EpiScaleBf16 E{D1, 0.5f}; GEMM(EpiScaleBf16, E, ACT, ws + WS_WD1, DM, DFF, DFF); }
#endif
    GSYNC();
    for (int m = gw; m < T; m += NGW) norm_row(xrow(p, m), D1 + (size_t)m * DM, p.in[6], XN + (size_t)m * DM, nullptr, lane);
    GSYNC();
#ifndef NO_EpiZ
    { EpiZ E{ZA, ZRKV, ZL}; GEMM(EpiZ, E, XN, ws + WS_WIN, 2816, DM, DM); }
#endif
    GSYNC();
    for (int m = gw; m < T; m += NGW) p5_row(p, m, lane);
    GSYNC();
#ifndef NO_EpiPlain
    { EpiPlain E{Qb, 768}; GEMM(EpiPlain, E, ZA, ws + WS_WUQ, 768, 384, 768); }
#endif
#ifndef NO_EpiKV
    { EpiKV E{Kb, Vb}; GEMM(EpiKV, E, ZA + 384, ws + WS_WUKV, 1024, 256, 768); }
#endif
    GSYNC();
#ifndef NO_ATT
    for (int rep_ = 0; rep_ < NREP_ATT; ++rep_) {
        char* ldsg = (char*)lds_raw;
        if (G == 256) {
            const int xcd = vcu >> 5, j = vcu & 31;
            for (int i = 0; i < 2; ++i) { const int head = xcd, qb = j + 32 * i; const size_t r0 = (size_t)TP + (size_t)qb * 256;
                att::attn_unit(Qb + r0 * 768 + head * 96, Kb + (size_t)TP * 768 + head * 96, Vb + (size_t)TP * 512 + head * 64, MIX + r0 * 1024 + head * 64, 16384, ldsg, rope, qb * 256); }
            for (int i = 0; i < 4; ++i) { const int pi = 4 * xcd + i, seq = pi >> 3, head = pi & 7; const size_t sb = (size_t)seq * 8192, r0 = sb + (size_t)j * 256;
                att::attn_unit(Qb + r0 * 768 + head * 96, Kb + sb * 768 + head * 96, Vb + sb * 512 + head * 64, MIX + r0 * 1024 + head * 64, 8192, ldsg, rope, j * 256); }
        } else {
            for (int u = vcu; u < 1536; u += G) {
                size_t sb, r0; int head, L;
                if (u < 512) { head = u >> 6; sb = TP; r0 = sb + (size_t)(u & 63) * 256; L = 16384; }
                else { const int v = u - 512; const int seq = v >> 8; head = (v >> 5) & 7; sb = (size_t)seq * 8192; r0 = sb + (size_t)(v & 31) * 256; L = 8192; }
                att::attn_unit(Qb + r0 * 768 + head * 96, Kb + sb * 768 + head * 96, Vb + sb * 512 + head * 64, MIX + r0 * 1024 + head * 64, L, ldsg, rope, (int)(r0 - sb));
            }
        }
    }
#endif
    GSYNC();
#ifndef NO_EpiLora
    { EpiLora E{WA, MIX, p.in[14], p.in[16], 0}; GEMM(EpiLora, E, LIN, ws + WS_WL, 1024, 128, 384); }
    { EpiLora E{WA, MIX, p.in[14], p.in[16], 2}; GEMM(EpiLora, E, LIN + 128, ws + WS_WL + 262144, 1024, 128, 384); }
    { EpiLora E{WA, MIX, p.in[14], p.in[16], 4}; GEMM(EpiLora, E, LIN + 256, ws + WS_WL + 524288, 512, 128, 384); }
#endif
    GSYNC();
#ifndef NO_SCAN
    {
        if (G == 256 && vcu >= 224) { prologue(p, lds, (vcu - 224) * 8 + wave, 32 * 8, wave, lane, 0, 1, 2);
            for (int m = (vcu - 224) * 8 + wave; m < T; m += 32 * 8) p10_att_row(p, m, lane); }
        for (int item = vcu; item < 224; item += G) {
            int sb_, L_, head_, dir_, part_ = item & 1, step0_ = 0, mode_ = 0; float* qcp_ = nullptr; float* smp_ = nullptr;
            if (item < 96) { const int kind = (item >> 1) % 3, hd = item / 6; head_ = hd >> 1; dir_ = hd & 1; sb_ = TP; L_ = 16384;
                qcp_ = (float*)(ws + (hd < 12 ? WS_QC0 + (size_t)hd * 2 * MiB : WS_QC1 + (size_t)(hd - 12) * 2 * MiB));
                if (kind == 0) smp_ = (float*)(ws + WS_SMID) + (size_t)hd * 4096; else step0_ = 8192;
                mode_ = kind == 2 ? 1 : 0; }
            else { const int j = (item - 96) >> 1; sb_ = (j >> 4) * 8192; L_ = 8192; head_ = (j >> 1) & 7; dir_ = j & 1; }
            scan_item<2, 4>(p, lds, sb_, L_, head_, dir_, part_, step0_, 8192, mode_, qcp_, smp_);
            __syncthreads();
        }
    }
    GSYNC();
    for (int it = vcu; it < 16 * 64; it += G) scan_fix_item(p, lds, it >> 6, it & 63);
#endif
    GSYNC();
    for (int m = gw; m < T; m += NGW) { if (G != 256) p10_att_row(p, m, lane); p10_row(p, m, lane); }
    GSYNC();
#ifndef NO_EpiOut
    { EpiOut E{p.in[0], p.in[1], D1}; GEMM(EpiOut, E, MIX, ws + WS_WOUT, DM, DM, DM); }
#endif
    GSYNC();
    for (int m = gw; m < T; m += NGW) norm_row_bf(D1 + (size_t)m * DM, p.in[25], XN + (size_t)m * DM, nullptr, lane);
    GSYNC();
#ifndef NO_EpiSwiGLU
    { EpiSwiGLU E{ACT}; GEMM(EpiSwiGLU, E, XN, ws + WS_WGU2, 2 * DFF, DM, DM); }
#endif
    GSYNC();
#ifndef NO_EpiDown2
    { EpiDown2 E{D1}; GEMM(EpiDown2, E, ACT, ws + WS_WD2, DM, DFF, DFF); }
#endif
    GSYNC();
    for (int m = gw; m < T; m += NGW) norm_row_bf(D1 + (size_t)m * DM, p.in[29], nullptr, H + (size_t)m * DM, lane);
}

extern "C" void kernel_launch(void* const* d_in, const int* in_sizes, int n_in, void* d_out, int out_size, void* d_ws, size_t ws_size, hipStream_t stream) {
    static int grid = 0;
    if (grid == 0) {
        if (n_in != 30 || in_sizes[0] != TP * DM || in_sizes[1] != TS * DM || out_size != T * DM || ws_size < WS_END) {
            fprintf(stderr, "kernel_launch: unexpected shapes: n_in %d in0 %d in1 %d out %d ws %zu (need >= %zu)\n", n_in, n_in > 0 ? in_sizes[0] : -1, n_in > 1 ? in_sizes[1] : -1, out_size, ws_size, (size_t)WS_END);
            grid = -1; return; }
        int dev = 0, cus = 0, per_cu = 0;
        if (hipGetDevice(&dev) != hipSuccess || hipDeviceGetAttribute(&cus, hipDeviceAttributeMultiprocessorCount, dev) != hipSuccess) { fprintf(stderr, "kernel_launch: device query failed\n"); grid = -1; return; }
        if (hipFuncSetAttribute((const void*)mega_fwd, hipFuncAttributeMaxDynamicSharedMemorySize, LDS_BYTES) != hipSuccess) { fprintf(stderr, "kernel_launch: hipFuncSetAttribute failed\n"); grid = -1; return; }
        if (hipOccupancyMaxActiveBlocksPerMultiprocessor(&per_cu, (const void*)mega_fwd, 512, LDS_BYTES) != hipSuccess || per_cu < 1) { fprintf(stderr, "kernel_launch: occupancy query says %d\n", per_cu); per_cu = 1; }
        (void)hipGetLastError();
        grid = cus * 1;
    }
    if (grid < 0) return;
    (void)hipMemsetAsync((char*)d_ws + WS_CTL, 0, WS_ZERO_BYTES, stream);
    Args a{};
    for (int i = 0; i < 30; ++i) a.in[i] = (const float*)d_in[i];
    a.out = (float*)d_out; a.ws = (unsigned char*)d_ws;
    void* args[] = {&a};
    hipError_t e = hipLaunchCooperativeKernel((const void*)mega_fwd, dim3(grid), dim3(512), args, LDS_BYTES, stream);
    if (e != hipSuccess) fprintf(stderr, "kernel_launch: cooperative launch failed: %s (grid %d)\n", hipGetErrorString(e), grid);
}
```

```cpp
#include <hip/hip_runtime.h>
#include <hip/hip_cooperative_groups.h>
#include <hip/hip_bf16.h>
#include <cstdio>
#include <cstdint>
namespace cg = cooperative_groups;
namespace pg8 {
#define PG8_LAS __attribute__((address_space(3)))
typedef unsigned short bf16_t;
typedef short bf16x8 __attribute__((ext_vector_type(8)));
typedef float f32x4 __attribute__((ext_vector_type(4)));
typedef unsigned u32x4 __attribute__((ext_vector_type(4)));
constexpr int BM = 256, BK = 64, HALF = 128, HTB = HALF * BK * 2  , STAGE_BYTES = 8 * HTB, NXCD = 8, WGM = 8;

__host__ __device__ __forceinline__ int lds_byte(int r, int c) { const int st = (r >> 4) * 2 + (c >> 5), rr = r & 15, cc = c & 31, ob = rr * 64 + cc * 2; return st * 1024 + (ob ^ (((ob >> 9) & 1) << 5)); }
__host__ __device__ __forceinline__ void stage_rc(int b, int& R, int& C) { const int st = b / 1024, sb = b % 1024, swz = sb ^ (((sb >> 9) & 1) << 5); R = (st >> 1) * 16 + swz / 64; C = (st & 1) * 32 + (swz % 64) / 2; }
__host__ __device__ __forceinline__ int perm32(int rho) { const int n = rho >> 4, i = rho & 15; return 8 * (i >> 2) + 4 * n + (i & 3); }

struct Unit { int pm, pn; };
struct Gemm { const bf16_t* A; const bf16_t* Bt; int M, N, K, lda; };

struct StaticOrder {
    int nM, nN, nwg, G, c;
    __host__ __device__ void init(int M, int N, int G_, int c_) { nM = M / BM; nN = N / BM; nwg = nM * nN; G = G_; c = c_; }
    __host__ __device__ bool next(int i, Unit& u) const {
        const long L = (long)i * G + c; if (L >= nwg) return false;
        int wgid = (int)L; { const int q = nwg / NXCD, r = nwg % NXCD, xcd = wgid % NXCD, off = wgid / NXCD; wgid = (xcd < r ? xcd * (q + 1) : r * (q + 1) + (xcd - r) * q) + off; }
        const int nig = WGM * nN, gid = wgid / nig, fm = gid * WGM, gsz = (nM - fm) < WGM ? (nM - fm) : WGM;
        u.pm = fm + ((wgid % nig) % gsz); u.pn = (wgid % nig) / gsz; return true;
    }
    __device__ __forceinline__ void a_ready(const Unit&) const {}
    __device__ __forceinline__ void done(const Unit&) const {}
};

__device__ __forceinline__ unsigned cvt_pk_bf16(float lo, float hi) { unsigned r; asm volatile("v_cvt_pk_bf16_f32 %0, %1, %2" : "=v"(r) : "v"(lo), "v"(hi)); return r; }
typedef float f32x2 __attribute__((ext_vector_type(2)));
template <class Epi, class Sched, bool ALIGN_EPI = false, bool SP2 = false>
__device__ __forceinline__ void gemm_phase(PG8_LAS unsigned char* lds, const Gemm g, const Sched& S, const Epi& E) {
    int tid_ = threadIdx.x; asm volatile("" : "+v"(tid_));
    const int tid = tid_, wid = __builtin_amdgcn_readfirstlane(tid >> 6), lane = tid & 63, wr = wid >> 2, wc = wid & 3, fr = lane & 15, fq = lane >> 4;
    int K_ = g.K; asm volatile("" : "+s"(K_));
    const int K = K_, nt = K / BK;
    unsigned voffA[2], voffB[2];
#pragma unroll
    for (int i = 0; i < 2; ++i) { int R, C; stage_rc(tid * 16 + i * 8192, R, C); const int Rb = Epi::PERM ? ((R & ~31) + perm32(R & 31)) : R;
        voffA[i] = (unsigned)(R * g.lda + C) * 2u; voffB[i] = (unsigned)(Rb * K + C) * 2u; }
    const size_t kstep = (size_t)(BK * 2);
    const size_t hstepB = (size_t)HALF * K * 2, hstepA = (size_t)HALF * g.lda * 2;
    const size_t tstepA = 2 * hstepA, tstepB = 2 * hstepB;
    const unsigned ldsw = (unsigned)wid * 1024u;
    const int aoff = lds_byte(wr * 64 + fr, fq * 8), boff = lds_byte(wc * 32 + fr, fq * 8);
#define PG8_SA(b, h) (((b) * 2 + (h)) * HTB)
#define PG8_SB(b, h) ((4 + (b) * 2 + (h)) * HTB)
#define PG8_STAGE(bufoff, gbase, voff) do { _Pragma("unroll") for (int _i = 0; _i < 2; ++_i) \
        __builtin_amdgcn_global_load_lds((const unsigned*)((const char*)(gbase) + (voff)[_i]), (PG8_LAS unsigned*)(lds + (bufoff) + ldsw + _i * 8192), 16, 0, 0); } while (0)
#define PG8_LDA(dst, b, h) do { _Pragma("unroll") for (int m = 0; m < 4; ++m) _Pragma("unroll") for (int k = 0; k < 2; ++k) dst[m][k] = *(const PG8_LAS bf16x8*)(lds + PG8_SA(b, h) + aoff + m * 2048 + k * 1024); } while (0)
#define PG8_LDB(dst, b, h) do { _Pragma("unroll") for (int n = 0; n < 2; ++n) _Pragma("unroll") for (int k = 0; k < 2; ++k) dst[n][k] = *(const PG8_LAS bf16x8*)(lds + PG8_SB(b, h) + boff + n * 2048 + k * 1024); } while (0)
#define PG8_MMA(ai, bj, At, Bt) do { __builtin_amdgcn_s_setprio(1); _Pragma("unroll") for (int m = 0; m < 4; ++m) _Pragma("unroll") for (int n = 0; n < 2; ++n) _Pragma("unroll") for (int k = 0; k < 2; ++k) \
        acc[ai][bj][m][n] = __builtin_amdgcn_mfma_f32_16x16x32_bf16(Bt[n][k], At[m][k], acc[ai][bj][m][n], 0, 0, 0); __builtin_amdgcn_s_setprio(0); } while (0)
#define PG8_WAIT_V(n) asm volatile("s_waitcnt vmcnt(" #n ")" ::: "memory")
#define PG8_WAIT_L(n) asm volatile("s_waitcnt lgkmcnt(" #n ")" ::: "memory")
#define PG8_BAR __builtin_amdgcn_s_barrier()
#define PG8_SCHED __builtin_amdgcn_sched_barrier(0)
    Unit cur, nxt; int ui = 0;
    if (!S.next(0, cur)) return;
    f32x4 acc[2][2][4][2];
#pragma unroll
    for (int a = 0; a < 2; ++a)
#pragma unroll
        for (int b = 0; b < 2; ++b)
#pragma unroll
            for (int m = 0; m < 4; ++m)
#pragma unroll
                for (int n = 0; n < 2; ++n) acc[a][b][m][n] = (f32x4){0.f, 0.f, 0.f, 0.f};
    bf16x8 At[4][2], B0[2][2], B1[2][2];
    const char* cA = (const char*)g.A + (size_t)cur.pm * tstepA; const char* cB = (const char*)g.Bt + (size_t)cur.pn * tstepB;
    S.a_ready(cur);
    if constexpr (SP2) {
        PG8_STAGE(PG8_SB(0, 0), cB, voffB); PG8_STAGE(PG8_SB(0, 1), cB + hstepB, voffB); PG8_STAGE(PG8_SA(0, 0), cA, voffA); PG8_STAGE(PG8_SA(0, 1), cA + hstepA, voffA);
        if (wr == 1) PG8_BAR;
        PG8_WAIT_V(2); PG8_BAR;
        PG8_STAGE(PG8_SB(1, 0), cB + kstep, voffB); PG8_STAGE(PG8_SA(1, 0), cA + kstep, voffA); PG8_STAGE(PG8_SB(1, 1), cB + hstepB + kstep, voffB);
        PG8_WAIT_V(6); PG8_BAR;
    } else {
        PG8_STAGE(PG8_SB(0, 0), cB, voffB); PG8_STAGE(PG8_SA(0, 0), cA, voffA); PG8_STAGE(PG8_SB(0, 1), cB + hstepB, voffB); PG8_STAGE(PG8_SA(0, 1), cA + hstepA, voffA);
        if (wr == 1) PG8_BAR;
        PG8_WAIT_V(4); PG8_BAR;
        PG8_STAGE(PG8_SB(1, 0), cB + kstep, voffB); PG8_STAGE(PG8_SA(1, 0), cA + kstep, voffA); PG8_STAGE(PG8_SB(1, 1), cB + hstepB + kstep, voffB);
        PG8_WAIT_V(6); PG8_BAR;
    }
    for (;;) {
        const bool has_next = S.next(ui + 1, nxt);
        const char* nA = has_next ? (const char*)g.A + (size_t)nxt.pm * tstepA : cA; const char* nB = has_next ? (const char*)g.Bt + (size_t)nxt.pn * tstepB : cB;
        for (int t = 0; t < nt; t += 2) {
            const bool last = (t == nt - 2);
            const char* a1 = cA + (size_t)(t + 1) * kstep;
            const char* a2 = last ? nA : cA + (size_t)(t + 2) * kstep; const char* b2 = last ? nB : cB + (size_t)(t + 2) * kstep;
            const char* a3 = a2 + kstep; const char* b3 = b2 + kstep;
            if (last && has_next) S.a_ready(nxt);
            if constexpr (SP2) {
            PG8_LDB(B0, 0, 0); PG8_LDB(B1, 0, 1); PG8_SCHED; PG8_LDA(At, 0, 0); PG8_STAGE(PG8_SA(1, 1), a1 + hstepA, voffA);
            PG8_WAIT_V(8); PG8_WAIT_L(0); PG8_BAR; PG8_MMA(0, 0, At, B0); PG8_MMA(0, 1, At, B1); PG8_BAR; PG8_SCHED;
            PG8_LDA(At, 0, 1); PG8_STAGE(PG8_SB(0, 0), b2, voffB); PG8_STAGE(PG8_SB(0, 1), b2 + hstepB, voffB); PG8_STAGE(PG8_SA(0, 0), a2, voffA);
            PG8_WAIT_V(8); PG8_WAIT_L(0); PG8_BAR; PG8_MMA(1, 0, At, B0); PG8_MMA(1, 1, At, B1); PG8_BAR; PG8_SCHED;
            PG8_LDB(B0, 1, 0); PG8_LDB(B1, 1, 1); PG8_SCHED; PG8_LDA(At, 1, 0); PG8_STAGE(PG8_SA(0, 1), a2 + hstepA, voffA);
            PG8_WAIT_V(8); PG8_WAIT_L(0); PG8_BAR; PG8_MMA(0, 0, At, B0); PG8_MMA(0, 1, At, B1); PG8_BAR; PG8_SCHED;
            PG8_LDA(At, 1, 1); PG8_STAGE(PG8_SB(1, 0), b3, voffB); PG8_STAGE(PG8_SB(1, 1), b3 + hstepB, voffB); PG8_STAGE(PG8_SA(1, 0), a3, voffA);
            PG8_WAIT_V(8); PG8_WAIT_L(0); PG8_BAR; PG8_MMA(1, 0, At, B0); PG8_MMA(1, 1, At, B1); PG8_BAR; PG8_SCHED;
            } else {
            PG8_LDB(B0, 0, 0); PG8_SCHED; PG8_LDA(At, 0, 0); PG8_STAGE(PG8_SA(1, 1), a1 + hstepA, voffA);
            PG8_WAIT_L(8); PG8_BAR; PG8_WAIT_L(0); PG8_MMA(0, 0, At, B0); PG8_BAR; PG8_SCHED;
            PG8_LDB(B1, 0, 1); PG8_STAGE(PG8_SB(0, 0), b2, voffB);
            PG8_BAR; PG8_WAIT_L(0); PG8_MMA(0, 1, At, B1); PG8_BAR;
            PG8_LDA(At, 0, 1); PG8_STAGE(PG8_SA(0, 0), a2, voffA);
            PG8_BAR; PG8_WAIT_L(0); PG8_MMA(1, 0, At, B0); PG8_BAR; PG8_SCHED;
            PG8_STAGE(PG8_SB(0, 1), b2 + hstepB, voffB);
            PG8_WAIT_V(6); PG8_BAR; PG8_MMA(1, 1, At, B1); PG8_BAR;
            PG8_LDB(B0, 1, 0); PG8_SCHED; PG8_LDA(At, 1, 0); PG8_STAGE(PG8_SA(0, 1), a2 + hstepA, voffA);
            PG8_WAIT_L(8); PG8_BAR; PG8_WAIT_L(0); PG8_MMA(0, 0, At, B0); PG8_BAR; PG8_SCHED;
            PG8_LDB(B1, 1, 1); PG8_STAGE(PG8_SB(1, 0), b3, voffB);
            PG8_BAR; PG8_WAIT_L(0); PG8_MMA(0, 1, At, B1); PG8_BAR;
            PG8_LDA(At, 1, 1); PG8_STAGE(PG8_SA(1, 0), a3, voffA);
            PG8_BAR; PG8_WAIT_L(0); PG8_MMA(1, 0, At, B0); PG8_BAR; PG8_SCHED;
            PG8_STAGE(PG8_SB(1, 1), b3 + hstepB, voffB);
            PG8_WAIT_V(6); PG8_BAR; PG8_MMA(1, 1, At, B1); PG8_BAR;
            }
        }
        if constexpr (ALIGN_EPI) { if (wr == 0) PG8_BAR; }
        if constexpr (!Epi::AFTER_DRAIN) { E(acc, cur, wr, wc, fr, fq); S.done(cur); }
        if (!has_next) break;
#pragma unroll
        for (int a = 0; a < 2; ++a)
#pragma unroll
            for (int b = 0; b < 2; ++b)
#pragma unroll
                for (int m = 0; m < 4; ++m)
#pragma unroll
                    for (int n = 0; n < 2; ++n) acc[a][b][m][n] = (f32x4){0.f, 0.f, 0.f, 0.f};
        cur = nxt; cA = nA; cB = nB; ++ui;
        if constexpr (ALIGN_EPI) { if (wr == 1) PG8_BAR; }
    }
    PG8_WAIT_V(0);
    if constexpr (!ALIGN_EPI) { if (wr == 0) PG8_BAR; }
    PG8_BAR;
    if constexpr (Epi::AFTER_DRAIN) { E.fused(acc, cur, wr, wc, fr, fq, lds, wid, lane); S.done(cur); }
#undef PG8_SA
#undef PG8_SB
#undef PG8_STAGE
#undef PG8_LDA
#undef PG8_LDB
#undef PG8_MMA
#undef PG8_WAIT_V
#undef PG8_WAIT_L
#undef PG8_BAR
#undef PG8_SCHED
}
}

#define LAS __attribute__((address_space(3)))
typedef unsigned short bf16_t;
typedef float f32x4 __attribute__((ext_vector_type(4)));
typedef unsigned u32x4 __attribute__((ext_vector_type(4)));
typedef unsigned u32x2 __attribute__((ext_vector_type(2)));
typedef _Float16 h16x2 __attribute__((ext_vector_type(2)));
constexpr int DM = 1024, TP = 32768, TS = 16384, T = TP + TS, DFF = 2816, NH = 8;
constexpr float NORM_EPS = 1e-6f, LNX_EPS = 64e-5f;
constexpr size_t MiB = 1u << 20;
constexpr size_t WS_CTL = 0, WS_WL = 1 * MiB, WS_ZERO_BYTES = 3 * MiB, WS_ROPE = 3 * MiB;
constexpr size_t WS_WGU1 = 5 * MiB, WS_WD1 = 16 * MiB, WS_WGU2 = 21 * MiB + MiB / 2, WS_WD2 = 32 * MiB + MiB / 2, WS_WIN = 38 * MiB,
                 WS_WUQ = 43 * MiB + MiB / 2, WS_WUKV = WS_WUQ + 9 * MiB / 16, WS_WOUT = WS_WUKV + MiB / 2;
constexpr size_t WS_D1 = 48 * MiB, WS_ZRKV = 144 * MiB, WS_ZA = 288 * MiB, WS_ZL = 360 * MiB, WS_U = 408 * MiB, WS_END = 512 * MiB;
constexpr size_t WS_ACT = 144 * MiB, WS_MIX = 288 * MiB, WS_LIN = 408 * MiB, WS_Y = 408 * MiB;
constexpr size_t WS_BAR = 512 * 1024;
constexpr size_t WS_SMID = 0, WS_QC0 = 384 * MiB, WS_QC1 = 504 * MiB;
constexpr size_t WS_BS = 1 * MiB;
constexpr size_t DO_Q = 0, DO_K = 72 * MiB, DO_V = 144 * MiB, DO_WA = 0;
static_assert(WS_WOUT + 2 * MiB <= WS_D1, "weights overflow");
constexpr int LDS_BYTES = 147456;

__device__ const float ROPE_INV[16] = {1.000000000e+00f, 5.623413324e-01f, 3.162277639e-01f, 1.778279394e-01f, 1.000000015e-01f, 5.623412877e-02f, 3.162277862e-02f, 1.778279431e-02f,
                                       9.999999776e-03f, 5.623413250e-03f, 3.162277862e-03f, 1.778279431e-03f, 1.000000047e-03f, 5.623413017e-04f, 3.162277862e-04f, 1.778279402e-04f};

__device__ __forceinline__ float bflo(unsigned w) { return __uint_as_float(w << 16); }
__device__ __forceinline__ float bfhi(unsigned w) { return __uint_as_float(w & 0xffff0000u); }
__device__ __forceinline__ unsigned pkbf(float lo, float hi) { return pg8::cvt_pk_bf16(lo, hi); }
__device__ __forceinline__ unsigned pkh(float lo, float hi) { h16x2 v; v.x = (_Float16)lo; v.y = (_Float16)hi; return __builtin_bit_cast(unsigned, v); }
__device__ __forceinline__ float hlo(unsigned w) { h16x2 v = __builtin_bit_cast(h16x2, w); return (float)v.x; }
__device__ __forceinline__ float hhi(unsigned w) { h16x2 v = __builtin_bit_cast(h16x2, w); return (float)v.y; }
__device__ __forceinline__ void unpack8bf(const u32x4 w, float* f) { f[0] = bflo(w.x); f[1] = bfhi(w.x); f[2] = bflo(w.y); f[3] = bfhi(w.y); f[4] = bflo(w.z); f[5] = bfhi(w.z); f[6] = bflo(w.w); f[7] = bfhi(w.w); }
__device__ __forceinline__ void unpack8h(const u32x4 w, float* f) { f[0] = hlo(w.x); f[1] = hhi(w.x); f[2] = hlo(w.y); f[3] = hhi(w.y); f[4] = hlo(w.z); f[5] = hhi(w.z); f[6] = hlo(w.w); f[7] = hhi(w.w); }
__device__ __forceinline__ float wave_sum(float v) {
#pragma unroll
    for (int o = 1; o < 64; o <<= 1) v += __shfl_xor(v, o);
    return v;
}
__device__ __forceinline__ float fsigmoid(float x) { return __builtin_amdgcn_rcpf(1.f + __builtin_amdgcn_exp2f(-1.4426950408889634f * x)); }
__device__ __forceinline__ int seq_pos(int row) { return row < TP ? (row & 8191) : (row - TP); }

using pg8::Unit;
typedef const pg8::f32x4 (&AccRef)[2][2][4][2];

struct EpiSwiGLU {
    static constexpr bool PERM = true, AFTER_DRAIN = false; bf16_t* O;
    __device__ __forceinline__ void operator()(AccRef acc, const Unit& u, int wr, int wc, int fr, int fq) const {
        asm volatile("" : "+v"(fr), "+v"(fq));
        const int row0 = u.pm * 256 + wr * 64 + fr, col0 = u.pn * 128 + wc * 32 + 8 * fq;
#pragma unroll
        for (int ai = 0; ai < 2; ++ai)
#pragma unroll
            for (int m = 0; m < 4; ++m) {
                bf16_t* rowp = O + (size_t)(row0 + ai * 128 + m * 16) * DFF + col0;
                float o[8];
#pragma unroll
                for (int n = 0; n < 2; ++n)
#pragma unroll
                    for (int e = 0; e < 4; ++e) { const float g = acc[ai][0][m][n][e], up = acc[ai][1][m][n][e]; o[n * 4 + e] = g * fsigmoid(g) * up; }
                u32x4 w; w.x = pkbf(o[0], o[1]); w.y = pkbf(o[2], o[3]); w.z = pkbf(o[4], o[5]); w.w = pkbf(o[6], o[7]);
                *(u32x4*)rowp = w; __builtin_amdgcn_sched_barrier(0); asm volatile("" ::: "memory");
            }
    }
};
struct EpiScaleBf16 {
    static constexpr bool PERM = true, AFTER_DRAIN = false; bf16_t* O; float s;
    __device__ __forceinline__ void operator()(AccRef acc, const Unit& u, int wr, int wc, int fr, int fq) const {
        asm volatile("" : "+v"(fr), "+v"(fq));
        const int row0 = u.pm * 256 + wr * 64 + fr, col0 = u.pn * 256 + wc * 32 + 8 * fq;
#pragma unroll
        for (int ai = 0; ai < 2; ++ai)
#pragma unroll
            for (int m = 0; m < 4; ++m)
#pragma unroll
                for (int bj = 0; bj < 2; ++bj) {
                    const pg8::f32x4 v0 = acc[ai][bj][m][0] * s, v1 = acc[ai][bj][m][1] * s;
                    u32x4 w; w.x = pkbf(v0[0], v0[1]); w.y = pkbf(v0[2], v0[3]); w.z = pkbf(v1[0], v1[1]); w.w = pkbf(v1[2], v1[3]);
                    *(u32x4*)(O + (size_t)(row0 + ai * 128 + m * 16) * DM + col0 + bj * 128) = w; __builtin_amdgcn_sched_barrier(0); asm volatile("" ::: "memory");
                }
    }
};
struct EpiZ {
    static constexpr bool PERM = true, AFTER_DRAIN = false; bf16_t *ZA, *ZRKV, *ZL;
    __device__ __forceinline__ void operator()(AccRef acc, const Unit& u, int wr, int wc, int fr, int fq) const {
        asm volatile("" : "+v"(fr), "+v"(fq));
        bf16_t* base; int ldc, colt;
        if (u.pn < 3) { base = ZA; ldc = 768; colt = u.pn * 256; } else if (u.pn < 9) { base = ZRKV; ldc = 1536; colt = (u.pn - 3) * 256; } else { base = ZL; ldc = 512; colt = (u.pn - 9) * 256; }
        const int row0 = u.pm * 256 + wr * 64 + fr, col0 = colt + wc * 32 + 8 * fq;
#pragma unroll
        for (int ai = 0; ai < 2; ++ai)
#pragma unroll
            for (int m = 0; m < 4; ++m)
#pragma unroll
                for (int bj = 0; bj < 2; ++bj) {
                    const pg8::f32x4 v0 = acc[ai][bj][m][0], v1 = acc[ai][bj][m][1];
                    u32x4 w; w.x = pkbf(v0[0], v0[1]); w.y = pkbf(v0[2], v0[3]); w.z = pkbf(v1[0], v1[1]); w.w = pkbf(v1[2], v1[3]);
                    *(u32x4*)(base + (size_t)(row0 + ai * 128 + m * 16) * ldc + col0 + bj * 128) = w; __builtin_amdgcn_sched_barrier(0); asm volatile("" ::: "memory");
                }
    }
};
struct EpiPlain {
    static constexpr bool PERM = true, AFTER_DRAIN = false; bf16_t* O; int ldc;
    __device__ __forceinline__ void operator()(AccRef acc, const Unit& u, int wr, int wc, int fr, int fq) const {
        asm volatile("" : "+v"(fr), "+v"(fq));
        const int row0 = u.pm * 256 + wr * 64 + fr, col0 = u.pn * 256 + wc * 32 + 8 * fq;
#pragma unroll
        for (int ai = 0; ai < 2; ++ai)
#pragma unroll
            for (int m = 0; m < 4; ++m)
#pragma unroll
                for (int bj = 0; bj < 2; ++bj) {
                    const pg8::f32x4 v0 = acc[ai][bj][m][0], v1 = acc[ai][bj][m][1];
                    u32x4 w; w.x = pkbf(v0[0], v0[1]); w.y = pkbf(v0[2], v0[3]); w.z = pkbf(v1[0], v1[1]); w.w = pkbf(v1[2], v1[3]);
                    *(u32x4*)(O + (size_t)(row0 + ai * 128 + m * 16) * ldc + col0 + bj * 128) = w;
                }
    }
};
struct EpiKV {
    static constexpr bool PERM = true, AFTER_DRAIN = false; bf16_t *K, *V;
    __device__ __forceinline__ void operator()(AccRef acc, const Unit& u, int wr, int wc, int fr, int fq) const {
        asm volatile("" : "+v"(fr), "+v"(fq));
        const int row0 = u.pm * 256 + wr * 64 + fr;
        const bool isk = u.pn < 2; bf16_t* base = isk ? K : V; const int ldc = isk ? 768 : 512;
#pragma unroll
        for (int bj = 0; bj < 2; ++bj) {
            const int c0 = (u.pn & 1) * 256 + bj * 128 + wc * 32 + 8 * fq;
            const int cc = isk ? (c0 >> 6) * 96 + (c0 & 63) : c0;
#pragma unroll
            for (int ai = 0; ai < 2; ++ai)
#pragma unroll
                for (int m = 0; m < 4; ++m) {
                    const pg8::f32x4 v0 = acc[ai][bj][m][0], v1 = acc[ai][bj][m][1];
                    u32x4 w; w.x = pkbf(v0[0], v0[1]); w.y = pkbf(v0[2], v0[3]); w.z = pkbf(v1[0], v1[1]); w.w = pkbf(v1[2], v1[3]);
                    *(u32x4*)(base + (size_t)(row0 + ai * 128 + m * 16) * ldc + cc) = w;
                }
        }
    }
};
struct EpiLora {
    static constexpr bool PERM = true, AFTER_DRAIN = false; unsigned short* WA; bf16_t* MIX; const float *w0, *a0; int seg0;
    template <int MODE> __device__ __forceinline__ void run(AccRef acc, const Unit& u, int wr, int wc, int fr, int fq) const {
        const int row0 = u.pm * 256 + wr * 64 + fr, seg = seg0 + (u.pn >> 1);
#pragma unroll
        for (int bj = 0; bj < 2; ++bj) {
            const int cc = (u.pn & 1) * 256 + bj * 128 + wc * 32 + 8 * fq;
            float bias[8];
            if (MODE < 2) { const float* bp = (MODE == 0 ? w0 + seg * 512 : a0 + (seg - 2) * 512) + cc; const f32x4 b0 = *(const f32x4*)bp, b1 = *(const f32x4*)(bp + 4);
                bias[0] = b0[0]; bias[1] = b0[1]; bias[2] = b0[2]; bias[3] = b0[3]; bias[4] = b1[0]; bias[5] = b1[1]; bias[6] = b1[2]; bias[7] = b1[3]; }
            else {
#pragma unroll
                for (int e = 0; e < 8; ++e) bias[e] = 0.f; }
#pragma unroll
            for (int ai = 0; ai < 2; ++ai)
#pragma unroll
                for (int m = 0; m < 4; ++m) {
                    const int row = row0 + ai * 128 + m * 16;
                    float x[8];
#pragma unroll
                    for (int e = 0; e < 4; ++e) { x[e] = acc[ai][bj][m][0][e] + bias[e]; x[4 + e] = acc[ai][bj][m][1][e] + bias[4 + e]; }
                    u32x4 w;
                    if (MODE == 0) {
#pragma unroll
                        for (int e = 0; e < 8; ++e) { const float sp = __logf(1.f + __expf(-x[e])); x[e] = __expf(-__expf(-sp - 0.5f)); }
                        w.x = pkh(x[0], x[1]); w.y = pkh(x[2], x[3]); w.z = pkh(x[4], x[5]); w.w = pkh(x[6], x[7]);
                        *(u32x4*)(WA + (size_t)row * 2048 + seg * 512 + cc) = w;
                    } else if (MODE == 1) {
#pragma unroll
                        for (int e = 0; e < 8; ++e) x[e] = fsigmoid(x[e]);
                        w.x = pkh(x[0], x[1]); w.y = pkh(x[2], x[3]); w.z = pkh(x[4], x[5]); w.w = pkh(x[6], x[7]);
                        *(u32x4*)(WA + (size_t)row * 2048 + seg * 512 + cc) = w;
                    } else {
                        w.x = pkbf(x[0], x[1]); w.y = pkbf(x[2], x[3]); w.z = pkbf(x[4], x[5]); w.w = pkbf(x[6], x[7]);
                        *(u32x4*)(MIX + (size_t)row * 1024 + 512 + cc) = w;
                    }
                    __builtin_amdgcn_sched_barrier(0); asm volatile("" ::: "memory");
                }
        }
    }
    __device__ __forceinline__ void operator()(AccRef acc, const Unit& u, int wr, int wc, int fr, int fq) const {
        asm volatile("" : "+v"(fr), "+v"(fq));
        const int seg = seg0 + (u.pn >> 1);
        if (seg < 2) run<0>(acc, u, wr, wc, fr, fq); else if (seg < 4) run<1>(acc, u, wr, wc, fr, fq); else run<2>(acc, u, wr, wc, fr, fq);
    }
};
struct EpiOut {
    static constexpr bool PERM = true, AFTER_DRAIN = false; const float *xp, *xs; bf16_t* D1;
    __device__ __forceinline__ void operator()(AccRef acc, const Unit& u, int wr, int wc, int fr, int fq) const {
        asm volatile("" : "+v"(fr), "+v"(fq));
        const int row0 = u.pm * 256 + wr * 64 + fr, col0 = u.pn * 256 + wc * 32 + 8 * fq;
        const float* xb = (u.pm * 256 < TP) ? xp : xs - (size_t)TP * DM;
#pragma unroll
        for (int ai = 0; ai < 2; ++ai)
#pragma unroll
            for (int m = 0; m < 4; ++m)
#pragma unroll
                for (int bj = 0; bj < 2; ++bj) {
                    const size_t off = (size_t)(row0 + ai * 128 + m * 16) * DM + col0 + bj * 128;
                    const f32x4 x0 = *(const f32x4*)(xb + off), x1 = *(const f32x4*)(xb + off + 4);
                    const u32x4 dw = *(const u32x4*)(D1 + off); float d[8]; unpack8bf(dw, d);
                    float o[8];
#pragma unroll
                    for (int e = 0; e < 4; ++e) { o[e] = x0[e] + d[e] + acc[ai][bj][m][0][e]; o[4 + e] = x1[e] + d[4 + e] + acc[ai][bj][m][1][e]; }
                    u32x4 w; w.x = pkbf(o[0], o[1]); w.y = pkbf(o[2], o[3]); w.z = pkbf(o[4], o[5]); w.w = pkbf(o[6], o[7]);
                    *(u32x4*)(D1 + off) = w;
                }
    }
};
struct EpiDown2 {
    static constexpr bool PERM = true, AFTER_DRAIN = false; bf16_t* Hb;
    __device__ __forceinline__ void operator()(AccRef acc, const Unit& u, int wr, int wc, int fr, int fq) const {
        asm volatile("" : "+v"(fr), "+v"(fq));
        const int row0 = u.pm * 256 + wr * 64 + fr, col0 = u.pn * 256 + wc * 32 + 8 * fq;
#pragma unroll
        for (int ai = 0; ai < 2; ++ai)
#pragma unroll
            for (int m = 0; m < 4; ++m)
#pragma unroll
                for (int bj = 0; bj < 2; ++bj) {
                    const size_t off = (size_t)(row0 + ai * 128 + m * 16) * DM + col0 + bj * 128;
                    const u32x4 hw = *(const u32x4*)(Hb + off); float h[8]; unpack8bf(hw, h);
#pragma unroll
                    for (int e = 0; e < 4; ++e) { h[e] += 0.5f * acc[ai][bj][m][0][e]; h[4 + e] += 0.5f * acc[ai][bj][m][1][e]; }
                    u32x4 w; w.x = pkbf(h[0], h[1]); w.y = pkbf(h[2], h[3]); w.z = pkbf(h[4], h[5]); w.w = pkbf(h[6], h[7]);
                    *(u32x4*)(Hb + off) = w;
                }
    }
};

__device__ __forceinline__ void transpose_item(const float* W, int N, int k0, int n0, bf16_t* WT, int ldk, int kdst0, int drow0, bool ropeperm, LAS float* scr, int lane, float sc = 1.f) {
#pragma unroll 8
    for (int i = 0; i < 32; ++i) { const int kk = 2 * i + (lane >> 5); scr[kk * 33 + (lane & 31)] = W[(size_t)(k0 + kk) * N + n0 + (lane & 31)]; }
    asm volatile("s_waitcnt lgkmcnt(0)" ::: "memory");
    const int c = lane & 7;
#pragma unroll
    for (int j = 0; j < 4; ++j) { const int n = (lane >> 3) + 8 * j; const LAS float* s = scr + (8 * c) * 33 + n;
        u32x4 o; o.x = pkbf(s[0 * 33] * sc, s[1 * 33] * sc); o.y = pkbf(s[2 * 33] * sc, s[3 * 33] * sc); o.z = pkbf(s[4 * 33] * sc, s[5 * 33] * sc); o.w = pkbf(s[6 * 33] * sc, s[7 * 33] * sc);
        const int dn = ropeperm ? (n < 16 ? 2 * n : 2 * (n - 16) + 1) : n;
        *(u32x4*)(WT + (size_t)(drow0 + dn) * ldk + kdst0 + k0 + 8 * c) = o; }
    asm volatile("s_waitcnt lgkmcnt(0)" ::: "memory");
}

struct Args { const float* in[30]; float* out; unsigned char* ws; };
typedef Args P;
__device__ __forceinline__ const float* xrow(const P& p, int row) { return row < TP ? p.in[0] + (size_t)row * DM : p.in[1] + (size_t)(row - TP) * DM; }

__device__ __forceinline__ void prologue(const P& p, LAS unsigned char* lds, int gw, int NGW, int wave, int lane, int gtid, int GT, int which) {
    LAS float* scr = (LAS float*)(lds + wave * 16384);
    unsigned char* ws = p.ws;
    constexpr int I_G = 16 * 88, I_D = 44 * 32, I_IN = 16 * 81, I_UQ = 6 * 24, I_UKV = 4 * 32, I_OUT = 16 * 32, I_L = 16, I_GL = 2 * 16;
    constexpr int NITEMS = 4 * I_G + 2 * I_D + I_IN + I_UQ + I_UKV + I_OUT + 4 * I_L + I_GL;
    for (int it = gw; it < NITEMS; it += NGW) {
        int r = it;
        if (r < 2 * (2 * I_G + I_D)) {
            const int f = r >= (2 * I_G + I_D) ? 1 : 0; r -= f * (2 * I_G + I_D);
            if ((which == 1 && f == 1) || (which == 2 && f == 0)) continue;
            bf16_t* WGU = (bf16_t*)(ws + (f ? WS_WGU2 : WS_WGU1)); bf16_t* WD = (bf16_t*)(ws + (f ? WS_WD2 : WS_WD1));
            const float* wg = p.in[f ? 26 : 3]; const float* wu = p.in[f ? 27 : 4]; const float* wd = p.in[f ? 28 : 5];
            if (r < 2 * I_G) { const bool up = r >= I_G; const int q = up ? r - I_G : r; const int kb = q / 88, nb = q % 88, n0 = nb * 32;
                transpose_item(up ? wu : wg, DFF, kb * 64, n0, WGU, DM, 0, (n0 >> 7) * 256 + (n0 & 127) + (up ? 128 : 0), false, scr, lane); }
            else { r -= 2 * I_G; const int kb = r / 32, nb = r % 32; transpose_item(wd, DM, kb * 64, nb * 32, WD, DFF, 0, nb * 32, false, scr, lane); }
            continue;
        }
        r -= 2 * (2 * I_G + I_D);
        { const bool is_out = (r >= I_IN + I_UQ + I_UKV) && (r < I_IN + I_UQ + I_UKV + I_OUT); if ((which == 1 && is_out) || (which == 2 && !is_out)) continue; }
        if (r < I_IN) { const int kb = r / 81, nb = r % 81, n0 = nb * 32; const int dr = n0 < 672 ? n0 : (n0 < 2208 ? 768 + (n0 - 672) : 2304 + (n0 - 2208));
            transpose_item(p.in[7], 2592, kb * 64, n0, (bf16_t*)(ws + WS_WIN), DM, 0, dr, false, scr, lane); continue; }
        r -= I_IN;
        if (r < I_UQ) { const int kb = r / 24, nb = r % 24; transpose_item(p.in[9], 768, kb * 64, nb * 32, (bf16_t*)(ws + WS_WUQ), 384, 0, nb * 32, (nb % 3) == 2, scr, lane, 0.10206207261596575f * 1.4426950408889634f); continue; }
        r -= I_UQ;
        if (r < I_UKV) { const int kb = r / 32, nb = r % 32, h = nb >> 2, part = nb & 3; const int dr = part < 2 ? h * 64 + part * 32 : 512 + h * 64 + (part - 2) * 32;
            transpose_item(p.in[11], 1024, kb * 64, nb * 32, (bf16_t*)(ws + WS_WUKV), 256, 0, dr, false, scr, lane); continue; }
        r -= I_UKV;
        if (r < I_OUT) { const int kb = r / 32, nb = r % 32; transpose_item(p.in[24], DM, kb * 64, nb * 32, (bf16_t*)(ws + WS_WOUT), DM, 0, nb * 32, false, scr, lane); continue; }
        r -= I_OUT;
        bf16_t* WL = (bf16_t*)(ws + WS_WL);
        if (r < 4 * I_L) { const int which = r / I_L, nb = r % I_L, d = which & 1; const bool isa = which >= 2;
            transpose_item(p.in[isa ? 17 : 15] + (size_t)d * 64 * 512, 512, 0, nb * 32, WL + (isa ? 131072 : 0), 128, d * 64, d * 512 + nb * 32, false, scr, lane); continue; }
        r -= 4 * I_L;
        { const int kb = r / 16, nb = r % 16; transpose_item(p.in[18], 512, kb * 64, nb * 32, WL + 262144, 128, 0, nb * 32, false, scr, lane); }
    }
    if (which == 2) return;
    { bf16_t* WIN = (bf16_t*)(ws + WS_WIN); const u32x4 z = {0u, 0u, 0u, 0u};
      for (int i = gtid; i < 224 * 128; i += GT) { const int rr = i >> 7, c = i & 127; const int row = rr < 96 ? 672 + rr : 2688 + (rr - 96); *(u32x4*)(WIN + (size_t)row * DM + c * 8) = z; } }
    { float* rope = (float*)(ws + WS_ROPE);
      for (int i = gtid; i < 16384 * 16; i += GT) { const int t = i >> 4, k = i & 15; const float ang = (float)t * ROPE_INV[k];
        const double a = (double)ang; const double n = rint(a * 0.15915494309189535); const double rr = a - n * 6.283185307179586; const float rf = (float)rr;
        rope[2 * i] = cosf(rf); rope[2 * i + 1] = sinf(rf); } }
}

__device__ __forceinline__ void norm_row(const float* src, const bf16_t* add, const float* gain, bf16_t* ob, float* of, int lane) {
    f32x4 v[4]; float s = 0.f;
#pragma unroll
    for (int j = 0; j < 4; ++j) { v[j] = *((const f32x4*)src + lane + 64 * j);
        if (add) { const u32x2 d = *((const u32x2*)add + lane + 64 * j); v[j][0] += bflo(d.x); v[j][1] += bfhi(d.x); v[j][2] += bflo(d.y); v[j][3] += bfhi(d.y); }
        s += (v[j][0] * v[j][0] + v[j][1] * v[j][1]) + (v[j][2] * v[j][2] + v[j][3] * v[j][3]); }
    const float rstd = 1.0f / sqrtf(wave_sum(s) * (1.f / DM) + NORM_EPS);
#pragma unroll
    for (int j = 0; j < 4; ++j) { const f32x4 g = *((const f32x4*)gain + lane + 64 * j); const f32x4 o = v[j] * rstd * g;
        if (ob) { u32x2 w; w.x = pkbf(o[0], o[1]); w.y = pkbf(o[2], o[3]); *((u32x2*)ob + lane + 64 * j) = w; }
        else *((f32x4*)of + lane + 64 * j) = o; }
}

__device__ __forceinline__ void norm_row_bf(const bf16_t* src, const float* gain, bf16_t* ob, float* of, int lane) {
    float v[16]; float s = 0.f;
    const u32x4 w0 = *((const u32x4*)src + lane), w1 = *((const u32x4*)src + lane + 64);
    unpack8bf(w0, v); unpack8bf(w1, v + 8);
#pragma unroll
    for (int e = 0; e < 16; ++e) s += v[e] * v[e];
    const float rstd = 1.0f / sqrtf(wave_sum(s) * (1.f / DM) + NORM_EPS);
#pragma unroll
    for (int h = 0; h < 2; ++h) { const float* g = gain + h * 512 + lane * 8; const f32x4 g0 = *(const f32x4*)g, g1 = *(const f32x4*)(g + 4);
        float o[8];
#pragma unroll
        for (int e = 0; e < 4; ++e) { o[e] = v[h * 8 + e] * rstd * g0[e]; o[4 + e] = v[h * 8 + 4 + e] * rstd * g1[e]; }
        if (ob) { u32x4 w; w.x = pkbf(o[0], o[1]); w.y = pkbf(o[2], o[3]); w.z = pkbf(o[4], o[5]); w.w = pkbf(o[6], o[7]); *((u32x4*)ob + lane + 64 * h) = w; }
        else { const f32x4 a = {o[0], o[1], o[2], o[3]}, b = {o[4], o[5], o[6], o[7]}; *(f32x4*)(of + h * 512 + lane * 8) = a; *(f32x4*)(of + h * 512 + lane * 8 + 4) = b; } }
}

__device__ __forceinline__ void p5_row(const P& p, int row, int lane) {
    unsigned char* ws = p.ws;
    bf16_t* za = (bf16_t*)(ws + WS_ZA) + (size_t)row * 768;
    { unsigned* q = (unsigned*)(za + lane * 6); const unsigned w0 = q[0], w1 = q[1], w2 = q[2];
      float f[6] = {bflo(w0), bfhi(w0), bflo(w1), bfhi(w1), bflo(w2), bfhi(w2)}; float s = 0.f;
#pragma unroll
      for (int e = 0; e < 6; ++e) s += f[e] * f[e];
      const float rstd = 1.0f / sqrtf(wave_sum(s) * (1.f / 384.f) + NORM_EPS); const float* g = p.in[8] + lane * 6;
#pragma unroll
      for (int e = 0; e < 6; ++e) f[e] = f[e] * rstd * g[e];
      q[0] = pkbf(f[0], f[1]); q[1] = pkbf(f[2], f[3]); q[2] = pkbf(f[4], f[5]); }
    { unsigned* q = (unsigned*)(za + 384 + lane * 4); const unsigned w0 = q[0], w1 = q[1];
      float f[4] = {bflo(w0), bfhi(w0), bflo(w1), bfhi(w1)}; float s = 0.f;
#pragma unroll
      for (int e = 0; e < 4; ++e) s += f[e] * f[e];
      const float rstd = 1.0f / sqrtf(wave_sum(s) * (1.f / 256.f) + NORM_EPS); const float* g = p.in[10] + lane * 4;
#pragma unroll
      for (int e = 0; e < 4; ++e) f[e] = f[e] * rstd * g[e];
      q[0] = pkbf(f[0], f[1]); q[1] = pkbf(f[2], f[3]); }
    if (lane < 16) { const float x1 = __uint_as_float((unsigned)za[640 + lane] << 16), x2 = __uint_as_float((unsigned)za[656 + lane] << 16);
      const float* rp = (const float*)(ws + WS_ROPE) + ((size_t)seq_pos(row) * 16 + lane) * 2; const float c = rp[0], s = rp[1];
      const unsigned w = pkbf(x1 * c - x2 * s, x1 * s + x2 * c);
      unsigned* kr = (unsigned*)((bf16_t*)((unsigned char*)p.out + DO_K) + (size_t)row * 768 + 64) + lane;
#pragma unroll
      for (int h = 0; h < NH; ++h) kr[h * 48] = w; }
    { const int pos = seq_pos(row), L = row < TP ? 8192 : 16384;
      const bf16_t* zl = (const bf16_t*)(ws + WS_ZL) + (size_t)row * 512 + lane * 6;
      const unsigned* q = (const unsigned*)zl; const unsigned w0 = q[0], w1 = q[1], w2 = q[2];
      unsigned p0 = 0, p1 = 0, p2 = 0, n0 = 0, n1 = 0, n2 = 0;
      if (pos > 0) { const unsigned* qq = (const unsigned*)(zl - 512); p0 = qq[0]; p1 = qq[1]; p2 = qq[2]; }
      if (pos < L - 1) { const unsigned* qq = (const unsigned*)(zl + 512); n0 = qq[0]; n1 = qq[1]; n2 = qq[2]; }
      const float z[6] = {bflo(w0), bfhi(w0), bflo(w1), bfhi(w1), bflo(w2), bfhi(w2)};
      const float zp[6] = {bflo(p0), bfhi(p0), bflo(p1), bfhi(p1), bflo(p2), bfhi(p2)};
      const float zn[6] = {bflo(n0), bfhi(n0), bflo(n1), bfhi(n1), bflo(n2), bfhi(n2)};
      const float* mu0 = p.in[13] + 1536 + lane * 6; const float* mu1 = p.in[13] + 1920 + 1536 + lane * 6;
      float o[6];
#pragma unroll
      for (int e = 0; e < 6; ++e) { const int c = lane * 6 + e; const float zs = z[e] + mu0[e] * (zp[e] - z[e]) + mu1[e] * (zn[e] - z[e]);
        float r;
        if (c < 128) { const float t = __expf(2.f * zs); r = 1.f - 2.f * __builtin_amdgcn_rcpf(t + 1.f); }
        else if (c < 256) r = zs;
        else r = fsigmoid(zs);
        o[e] = r; }
      unsigned* lo = (unsigned*)((bf16_t*)(ws + WS_LIN) + (size_t)row * 384 + lane * 6);
      lo[0] = pkbf(o[0], o[1]); lo[1] = pkbf(o[2], o[3]); lo[2] = pkbf(o[4], o[5]); }
}

__device__ __forceinline__ void shift8(const bf16_t* base, int pitch, bool hasp, bool hasn, const float* mu0, const float* mu1, float* o) {
    const u32x4 w = *(const u32x4*)base; u32x4 wp = {0u, 0u, 0u, 0u}, wn = {0u, 0u, 0u, 0u};
    if (hasp) wp = *(const u32x4*)(base - pitch);
    if (hasn) wn = *(const u32x4*)(base + pitch);
    float z[8], zp[8], zn[8]; unpack8bf(w, z); unpack8bf(wp, zp); unpack8bf(wn, zn);
#pragma unroll
    for (int e = 0; e < 8; ++e) o[e] = z[e] + mu0[e] * (zp[e] - z[e]) + mu1[e] * (zn[e] - z[e]);
}
__device__ __forceinline__ float sum8(float v) { v += __shfl_xor(v, 1); v += __shfl_xor(v, 2); v += __shfl_xor(v, 4); return v; }
__device__ __forceinline__ void p10_att_row(const P& p, int row, int lane) {
    unsigned char* ws = p.ws;
    bf16_t* mix = (bf16_t*)(ws + WS_MIX) + (size_t)row * 1024;
    { u32x4* q = (u32x4*)(mix + lane * 8); const u32x4 w = *q; float f[8]; unpack8bf(w, f); float s = 0.f;
#pragma unroll
      for (int e = 0; e < 8; ++e) s += f[e] * f[e];
      const float rstd = 1.0f / sqrtf(wave_sum(s) * (1.f / 512.f) + NORM_EPS); const float* g = p.in[12] + lane * 8;
#pragma unroll
      for (int e = 0; e < 8; ++e) f[e] = f[e] * rstd * g[e];
      u32x4 o; o.x = pkbf(f[0], f[1]); o.y = pkbf(f[2], f[3]); o.z = pkbf(f[4], f[5]); o.w = pkbf(f[6], f[7]); *q = o; }
}
__device__ __forceinline__ void p10_row(const P& p, int row, int lane) {
    unsigned char* ws = p.ws;
    bf16_t* mix = (bf16_t*)(ws + WS_MIX) + (size_t)row * 1024;
    { const int c = lane * 8; const int pos = seq_pos(row), L = row < TP ? 8192 : 16384; const bool hasp = pos > 0, hasn = pos < L - 1;
      const float* mu = p.in[13];
      const bf16_t* zr = (const bf16_t*)(ws + WS_ZRKV) + (size_t)row * 1536 + c;
      float v[8];
      shift8(zr + 1024, 1536, hasp, hasn, mu + 1024 + c, mu + 1920 + 1024 + c, v);
      float g[8]; unpack8bf(*(const u32x4*)(mix + 512 + c), g);
      const bf16_t* yp = (const bf16_t*)(ws + WS_Y) + (size_t)row * 512 + c;
      float y[8], yb2[8]; unpack8bf(*(const u32x4*)yp, y); unpack8bf(*(const u32x4*)(yp + (size_t)T * 512), yb2);
#pragma unroll
      for (int e = 0; e < 8; ++e) y[e] += yb2[e];
      float s = 0.f;
#pragma unroll
      for (int e = 0; e < 8; ++e) s += y[e];
      const float mean = sum8(s) * (1.f / 64.f); float q = 0.f;
#pragma unroll
      for (int e = 0; e < 8; ++e) { y[e] -= mean; q += y[e] * y[e]; }
      const float rstd = 1.0f / sqrtf(sum8(q) * (1.f / 64.f) + LNX_EPS);
      const float* lw = p.in[22] + c; const float* lb = p.in[23] + c;
      const float* bsp = (const float*)(ws + WS_BS) + (size_t)row * 8 + (lane >> 3);
      const float bs = bsp[0] + bsp[(size_t)T * 8];
      float o[8];
#pragma unroll
      for (int e = 0; e < 8; ++e) o[e] = (y[e] * rstd * lw[e] + lb[e] + bs * v[e]) * g[e];
      u32x4 w; w.x = pkbf(o[0], o[1]); w.y = pkbf(o[2], o[3]); w.z = pkbf(o[4], o[5]); w.w = pkbf(o[6], o[7]);
      *(u32x4*)(mix + 512 + c) = w; }
}

namespace att {
using bf16x8 = __attribute__((ext_vector_type(8))) short;
using s16x4  = __attribute__((ext_vector_type(4))) short;
using f32x16 = __attribute__((ext_vector_type(16))) float;
constexpr int NW = 8, QBLK = 32, KVBLK = 64, LDQ = 768, LDK = 768, LDV = 512, LDO = 1024;
constexpr float SCALE = 0.10206207261596575f, THR = 8.f;
constexpr int SHM_V = 16384, SHM_K = 16384, NBUF = 3, SHM_ATTN = NBUF * SHM_V + NBUF * SHM_K + NW * 64 * 4;
#define KSWZ(row, colB) ((row) * 256 + ((colB) ^ (((row) & 7) << 4)))
#define SBAR() __builtin_amdgcn_sched_barrier(0)
__device__ __forceinline__ int crow(int r, int hi) { return (r & 3) + 8 * (r >> 2) + 4 * hi; }
__device__ __forceinline__ unsigned cvtpk(float lo, float hi) { unsigned r; asm volatile("v_cvt_pk_bf16_f32 %0, %1, %2" : "=v"(r) : "v"(lo), "v"(hi)); return r; }
constexpr float THRL = 11.5415603f;
template <bool FIRST>
__device__ __forceinline__ void partialSM(f32x16& p0, f32x16& p1, float& m_reg, float& alpha) {
  float a = fmaxf(fmaxf(p0[0], p0[1]), p0[2]), b = fmaxf(fmaxf(p1[0], p1[1]), p1[2]);
#pragma unroll
  for (int r = 3; r < 15; r += 2) { a = fmaxf(fmaxf(a, p0[r]), p0[r + 1]); b = fmaxf(fmaxf(b, p1[r]), p1[r + 1]); }
  float pmax = fmaxf(fmaxf(a, b), fmaxf(p0[15], p1[15]));
  { auto rr = __builtin_amdgcn_permlane32_swap(__float_as_uint(pmax), __float_as_uint(pmax), false, false);
    pmax = fmaxf(__uint_as_float(rr[0]), __uint_as_float(rr[1])); }
  alpha = 1.f;
  if (FIRST || !__builtin_expect(__all(pmax <= THRL), 1)) {
    const float dl = FIRST ? pmax : fmaxf(pmax, 0.f);
    m_reg += dl; if (!FIRST) alpha = __builtin_amdgcn_exp2f(-dl);
#pragma unroll
    for (int r = 0; r < 16; ++r) { p0[r] -= dl; p1[r] -= dl; }
  }
#pragma unroll
  for (int r = 0; r < 16; ++r) p0[r] = __builtin_amdgcn_exp2f(p0[r]);
}
__device__ __forceinline__ void finishSM(f32x16& p0, f32x16& p1, float alpha, float& l_reg, bf16x8& pa0, bf16x8& pa1, bf16x8& pa2, bf16x8& pa3) {
#pragma unroll
  for (int r = 0; r < 16; ++r) p1[r] = __builtin_amdgcn_exp2f(p1[r]);
  typedef float f2_t __attribute__((ext_vector_type(2)));
  f2_t s2a = {p0[0], p0[1]}, s2b = {p1[0], p1[1]};
#pragma unroll
  for (int r = 2; r < 16; r += 2) { s2a += (f2_t){p0[r], p0[r + 1]}; s2b += (f2_t){p1[r], p1[r + 1]}; }
  s2a += s2b; float ps = s2a.x + s2a.y;
  { auto rr = __builtin_amdgcn_permlane32_swap(__float_as_uint(ps), __float_as_uint(ps), false, false);
    ps = __uint_as_float(rr[0]) + __uint_as_float(rr[1]); }
  l_reg = l_reg * alpha + ps;
#define PK4(PP, BASE, OUT) do { unsigned a0 = cvtpk(PP[BASE + 0], PP[BASE + 1]), a1 = cvtpk(PP[BASE + 2], PP[BASE + 3]);   \
    unsigned b0 = cvtpk(PP[BASE + 4], PP[BASE + 5]), b1 = cvtpk(PP[BASE + 6], PP[BASE + 7]);                              \
    auto r0 = __builtin_amdgcn_permlane32_swap(a0, b0, false, false); auto r1 = __builtin_amdgcn_permlane32_swap(a1, b1, false, false); \
    u32x4 w = {r0[0], r1[0], r0[1], r1[1]}; OUT = *reinterpret_cast<bf16x8*>(&w); } while (0)
  PK4(p0, 0, pa0); PK4(p0, 8, pa1); PK4(p1, 0, pa2); PK4(p1, 8, pa3);
#undef PK4
}
__device__ __forceinline__ void qkt(f32x16& p0, f32x16& p1, const char* Ks, const bf16x8* qr, int r32, int hi, float m_reg) {
#pragma unroll
  for (int r = 0; r < 16; ++r) { p0[r] = -m_reg; p1[r] = -m_reg; }
#pragma unroll
  for (int d0 = 0; d0 < 6; ++d0) { int cb = (d0 * 16 + hi * 8) * 2;
    bf16x8 b0 = *reinterpret_cast<const bf16x8*>(Ks + KSWZ(r32, cb));
    bf16x8 b1 = *reinterpret_cast<const bf16x8*>(Ks + KSWZ(32 + r32, cb));
    p0 = __builtin_amdgcn_mfma_f32_32x32x16_bf16(b0, qr[d0], p0, 0, 0, 0);
    p1 = __builtin_amdgcn_mfma_f32_32x32x16_bf16(b1, qr[d0], p1, 0, 0, 0); }
}
__device__ __forceinline__ int v_st(int k, int c) { const int kk = (k & ~0xC) | ((k & 4) << 1) | ((k & 8) >> 1); return ((kk >> 3) * 4 + (c >> 5)) * 512 + ((kk & 7) * 32 + (c & 31)) * 2; }
__device__ __forceinline__ int v_rd_base(int lane) { return ((lane & 3) << 3) | (((lane >> 2) & 3) << 6) | (((lane >> 4) & 1) << 5) | (((lane >> 5) & 1) << 8); }
constexpr int v_rd_off(int d0, int ks, int half) { return d0 * 512 + ks * 4096 + half * 2048; }
template <int OFF> __device__ __forceinline__ s16x4 tr_read(int vb) {
  s16x4 r; asm volatile("ds_read_b64_tr_b16 %0, %1 offset:%2" : "=&v"(r) : "v"(vb), "i"(OFF) : "memory"); return r;
}
template <int D0> __device__ __forceinline__ void pv_one(f32x16& od, int vb, bf16x8 pa0, bf16x8 pa1, bf16x8 pa2, bf16x8 pa3) {
  const s16x4 l0 = tr_read<v_rd_off(D0, 0, 0)>(vb), h0 = tr_read<v_rd_off(D0, 0, 1)>(vb), l1 = tr_read<v_rd_off(D0, 1, 0)>(vb), h1 = tr_read<v_rd_off(D0, 1, 1)>(vb);
  const s16x4 l2 = tr_read<v_rd_off(D0, 2, 0)>(vb), h2 = tr_read<v_rd_off(D0, 2, 1)>(vb), l3 = tr_read<v_rd_off(D0, 3, 0)>(vb), h3 = tr_read<v_rd_off(D0, 3, 1)>(vb);
  asm volatile("s_waitcnt lgkmcnt(0)" ::: "memory"); SBAR();
#define PKV(L, H) (bf16x8){L[0], L[1], L[2], L[3], H[0], H[1], H[2], H[3]}
  od = __builtin_amdgcn_mfma_f32_32x32x16_bf16(pa0, PKV(l0, h0), od, 0, 0, 0);
  od = __builtin_amdgcn_mfma_f32_32x32x16_bf16(pa1, PKV(l1, h1), od, 0, 0, 0);
  od = __builtin_amdgcn_mfma_f32_32x32x16_bf16(pa2, PKV(l2, h2), od, 0, 0, 0);
  od = __builtin_amdgcn_mfma_f32_32x32x16_bf16(pa3, PKV(l3, h3), od, 0, 0, 0);
#undef PKV
}
__device__ __forceinline__ void pv_d0(f32x16* o, int vb, bf16x8 pa0, bf16x8 pa1, bf16x8 pa2, bf16x8 pa3) {
  pv_one<0>(o[0], vb, pa0, pa1, pa2, pa3); pv_one<1>(o[1], vb, pa0, pa1, pa2, pa3);
}
__device__ __forceinline__ void attn_unit(const bf16_t* __restrict__ Qb, const bf16_t* __restrict__ Kh, const bf16_t* __restrict__ Vh, bf16_t* __restrict__ Ob, int seq, char* lds, const float* rope, int qpos0) {
  int tid_ = threadIdx.x; asm volatile("" : "+v"(tid_));
  const int tid = tid_, wid = tid >> 6, lane = tid & 63, r32 = lane & 31, hi = lane >> 5;
  char* V_lds = lds; char* K_lds = lds + NBUF * SHM_V;
  float* ws = (float*)(lds + NBUF * SHM_V + NBUF * SHM_K) + wid * 64; float* li_l = ws; float* al_l = ws + 32;
  float m_reg = 0.f, l_reg = 0; f32x16 o[2] = {}; bf16x8 qr[6];
  const bf16_t* Qw = Qb + (long)(wid * QBLK + r32) * LDQ + hi * 8;
#pragma unroll
  for (int d0 = 0; d0 < 6; ++d0) qr[d0] = *reinterpret_cast<const bf16x8*>(Qw + d0 * 16);
#pragma unroll
  for (int d0 = 4; d0 < 6; ++d0) {
    const float* rp = rope + ((size_t)(qpos0 + wid * QBLK + r32) * 16 + (d0 - 4) * 8 + hi * 4) * 2;
    const f32x4 t0 = *(const f32x4*)rp, t1 = *(const f32x4*)(rp + 4);
    float f[8]; unpack8bf(*reinterpret_cast<const u32x4*>(&qr[d0]), f);
    u32x4 w;
    w.x = cvtpk(f[0] * t0[0] - f[1] * t0[1], f[0] * t0[1] + f[1] * t0[0]);
    w.y = cvtpk(f[2] * t0[2] - f[3] * t0[3], f[2] * t0[3] + f[3] * t0[2]);
    w.z = cvtpk(f[4] * t1[0] - f[5] * t1[1], f[4] * t1[1] + f[5] * t1[0]);
    w.w = cvtpk(f[6] * t1[2] - f[7] * t1[3], f[6] * t1[3] + f[7] * t1[2]);
    qr[d0] = *reinterpret_cast<bf16x8*>(&w);
  }
  const int kr0 = tid / 12, kc0 = (tid % 12) * 8, kr1 = (512 + tid) / 12, kc1 = ((512 + tid) % 12) * 8; const bool k2 = __builtin_amdgcn_readfirstlane(tid) < 256;
  const int vr = tid >> 3, vc = (tid & 7) * 8, vst = v_st(vr, vc);
  const int kst0 = KSWZ(kr0, kc0 * 2), kst1 = KSWZ(kr1, kc1 * 2);
  const int vb0 = (int)(uintptr_t)V_lds + v_rd_base(lane);
  struct { bf16x8 vs, ks0, ks1; } sr_;
  const unsigned vo_ = (unsigned)(vr * LDV + vc) * 2u, ko0_ = (unsigned)(kr0 * LDK + kc0) * 2u, ko1_ = (unsigned)(kr1 * LDK + kc1) * 2u;
#define SLOAD(k0) do { const unsigned kt_ = (unsigned)(k0) * (LDK * 2u), vt_ = (unsigned)(k0) * (LDV * 2u); \
    sr_.vs = *reinterpret_cast<const bf16x8*>((const char*)Vh + (vo_ + vt_)); \
    sr_.ks0 = *reinterpret_cast<const bf16x8*>((const char*)Kh + (ko0_ + kt_)); \
    if (k2) sr_.ks1 = *reinterpret_cast<const bf16x8*>((const char*)Kh + (ko1_ + kt_)); } while (0)
#define SWRITE(bo) do { *(bf16x8*)(V_lds + (bo) + vst) = sr_.vs; *(bf16x8*)(K_lds + (bo) + kst0) = sr_.ks0; \
    if (k2) *(bf16x8*)(K_lds + (bo) + kst1) = sr_.ks1; } while (0)
#define RESC(a) do { if (__any((a) < 1.f)) { if (hi == 0) al_l[r32] = (a); asm volatile("s_waitcnt lgkmcnt(0)" ::: "memory"); \
    _Pragma("unroll") for (int d = 0; d < 2; ++d) _Pragma("unroll") for (int r = 0; r < 16; ++r) o[d][r] *= al_l[crow(r, hi)]; } } while (0)
#define ROT3() do { const int t_ = bp; bp = bc; bc = bn; bn = t_; } while (0)
  static_assert(SHM_V == SHM_K, "one ring offset serves both");
  f32x16 pA0, pA1, pB0, pB1; float alA, alB; bf16x8 pa0, pa1, pa2, pa3; const int NT = seq / KVBLK;
  int bp = 0, bc = SHM_K, bn = 2 * SHM_K;
  if (__builtin_amdgcn_readfirstlane(tid) >= 256) __builtin_amdgcn_s_setprio(1);
  SLOAD(0); SWRITE(0); SLOAD(KVBLK); __syncthreads();
  qkt(pA0, pA1, K_lds, qr, r32, hi, m_reg); partialSM<true>(pA0, pA1, m_reg, alA);
  SWRITE(SHM_K); SLOAD(2 * KVBLK); __syncthreads();
  for (int j = 1; j + 1 < NT; j += 2) {
    SBAR(); qkt(pB0, pB1, K_lds + bc, qr, r32, hi, m_reg);
    finishSM(pA0, pA1, alA, l_reg, pa0, pa1, pa2, pa3); SBAR();
    pv_d0(o, vb0 + bp, pa0, pa1, pa2, pa3); partialSM<false>(pB0, pB1, m_reg, alB);
    SWRITE(bn); SLOAD((j + 2) * KVBLK);
    RESC(alB); __syncthreads(); ROT3();
    SBAR(); qkt(pA0, pA1, K_lds + bc, qr, r32, hi, m_reg);
    finishSM(pB0, pB1, alB, l_reg, pa0, pa1, pa2, pa3); SBAR();
    pv_d0(o, vb0 + bp, pa0, pa1, pa2, pa3); partialSM<false>(pA0, pA1, m_reg, alA);
    SWRITE(bn); if (j + 3 < NT) SLOAD((j + 3) * KVBLK);
    RESC(alA); __syncthreads(); ROT3();
  }
  SBAR(); qkt(pB0, pB1, K_lds + bc, qr, r32, hi, m_reg);
  finishSM(pA0, pA1, alA, l_reg, pa0, pa1, pa2, pa3); SBAR();
  pv_d0(o, vb0 + bp, pa0, pa1, pa2, pa3); partialSM<false>(pB0, pB1, m_reg, alB);
  RESC(alB);
  finishSM(pB0, pB1, alB, l_reg, pa0, pa1, pa2, pa3); SBAR();
  pv_d0(o, vb0 + bc, pa0, pa1, pa2, pa3);
#undef ROT3
  if (hi == 0) li_l[r32] = l_reg; asm volatile("s_waitcnt lgkmcnt(0)" ::: "memory");
  float rli[16];
#pragma unroll
  for (int r = 0; r < 16; ++r) rli[r] = __builtin_amdgcn_rcpf(li_l[crow(r, hi)]);
  bf16_t* Ow = Ob + (long)(wid * QBLK) * LDO;
#pragma unroll
  for (int r = 0; r < 16; ++r) { int orow = crow(r, hi);
#pragma unroll
    for (int d0 = 0; d0 < 2; ++d0) { const float val = o[d0][r] * rli[r]; Ow[(long)orow * LDO + d0 * 32 + r32] = (bf16_t)(cvtpk(val, val) & 0xffffu); } }
  __builtin_amdgcn_s_setprio(0);
  __syncthreads();
#undef SLOAD
#undef SWRITE
#undef RESC
}
#undef KSWZ
#undef SBAR
}

typedef float f32x2 __attribute__((ext_vector_type(2)));
template <int CTRL> __device__ __forceinline__ float dppx(float v) { return __int_as_float(__builtin_amdgcn_update_dpp(0, __float_as_int(v), CTRL, 0xF, 0xF, true)); }
__device__ __forceinline__ float reduce16(float v) { v += dppx<0xB1>(v); v += dppx<0x4E>(v); v += dppx<0x141>(v); v += dppx<0x140>(v); return v; }
struct ScanRaw { u32x4 r[3], k[3], v[3], w, a; };
__device__ __forceinline__ void scan_load(ScanRaw& R, const bf16_t* zr, const unsigned short* wa, bool hasp, bool hasn) {
    const u32x4 z = {0u, 0u, 0u, 0u};
    R.r[1] = *(const u32x4*)zr; R.k[1] = *(const u32x4*)(zr + 512); R.v[1] = *(const u32x4*)(zr + 1024);
    R.r[0] = z; R.k[0] = z; R.v[0] = z; R.r[2] = z; R.k[2] = z; R.v[2] = z;
    if (hasp) { R.r[0] = *(const u32x4*)(zr - 1536); R.k[0] = *(const u32x4*)(zr - 1536 + 512); R.v[0] = *(const u32x4*)(zr - 1536 + 1024); }
    if (hasn) { R.r[2] = *(const u32x4*)(zr + 1536); R.k[2] = *(const u32x4*)(zr + 1536 + 512); R.v[2] = *(const u32x4*)(zr + 1536 + 1024); }
    R.w = *(const u32x4*)wa; R.a = *(const u32x4*)(wa + 1024);
}
__device__ __forceinline__ void shift8r(const u32x4 wp, const u32x4 w, const u32x4 wn, const float* mu0, const float* mu1, float* o) {
    float z[8], zp[8], zn[8]; unpack8bf(w, z); unpack8bf(wp, zp); unpack8bf(wn, zn);
#pragma unroll
    for (int e = 0; e < 8; ++e) o[e] = z[e] + mu0[e] * (zp[e] - z[e]) + mu1[e] * (zn[e] - z[e]);
}
template <int RPL, int NSW>
__device__ __forceinline__ void scan_item(const P& p, LAS unsigned char* lds, int seqbase, int L, int head, int dir, int part, int step0, int nsteps, int mode, float* qc, float* smid) {
    constexpr int WR = NSW * 4 * RPL, TC = 32, ARR = TC * 64;
    constexpr int BUF_FLOATS = 5 * ARR + 5 * TC * WR;
    static_assert(WR == 32, "flush mapping assumes 32 rows per workgroup");
    static_assert(2 * BUF_FLOATS * 4 <= 131072, "scan LDS");
    LAS float* lf = (LAS float*)lds;
    int tid_ = threadIdx.x; asm volatile("" : "+v"(tid_));
    const int tid = tid_, wave = __builtin_amdgcn_readfirstlane(tid >> 6), lane = tid & 63;
    const int rowbase = part * WR, NC = nsteps / TC;
    unsigned char* ws = p.ws;
    const bf16_t* ZR = (const bf16_t*)(ws + WS_ZRKV);
    const unsigned short* WA = (const unsigned short*)((unsigned char*)p.out + DO_WA);
    bf16_t* Yd = (bf16_t*)(ws + WS_Y) + (dir ? (size_t)T * 512 : 0);
    const bool is_scan = wave < NSW;
    const bool is_prod = (NSW == 4) ? (wave >= 4) : ((wave & 2) != 0);
    if (is_prod) {
        const int pw = (NSW == 4) ? (wave - 4) : (((wave >> 2) << 1) | (wave & 1));
        const int ptid = pw * 64 + lane, s = ptid >> 3, d0 = (ptid & 7) * 8, c = head * 64 + d0;
        float mu[6][8], kk_k[8], k_a[8], r_kk[8];
#pragma unroll
        for (int e = 0; e < 8; ++e) { mu[0][e] = p.in[13][c + e]; mu[1][e] = p.in[13][1920 + c + e]; mu[2][e] = p.in[13][512 + c + e]; mu[3][e] = p.in[13][1920 + 512 + c + e];
            mu[4][e] = p.in[13][1024 + c + e]; mu[5][e] = p.in[13][1920 + 1024 + c + e]; kk_k[e] = p.in[19][c + e]; k_a[e] = p.in[20][c + e]; r_kk[e] = p.in[21][c + e]; }
        float* BSd = (float*)(ws + WS_BS) + (size_t)dir * T * 8;
#define SCAN_FLUSH() do { const int r0_ = (ptid & 7) * 4; float o_[4]; \
            _Pragma("unroll") for (int i_ = 0; i_ < 4; ++i_) { const f32x4 pv_ = *(LAS const f32x4*)(yb + (s * WR + r0_ + i_) * 4); o_[i_] = (pv_[0] + pv_[1]) + (pv_[2] + pv_[3]); } \
            if (mode == 0) { u32x2 w_; w_.x = pkbf(o_[0], o_[1]); w_.y = pkbf(o_[2], o_[3]); *(u32x2*)(Yd + (size_t)(seqbase + t) * 512 + head * 64 + rowbase + r0_) = w_; } \
            else { const f32x4 q_ = {o_[0], o_[1], o_[2], o_[3]}; *(f32x4*)(qc + (size_t)(step - step0) * 64 + rowbase + r0_) = q_; } } while (0)
        ScanRaw cur, nxt;
        { const int t = dir ? (L - 1 - (step0 + s)) : (step0 + s); scan_load(cur, ZR + (size_t)(seqbase + t) * 1536 + c, WA + (size_t)(seqbase + t) * 2048 + dir * 512 + c, t > 0, t < L - 1); }
        nxt = cur;
        for (int ch = 0; ch <= NC; ++ch) {
            if (ch + 1 < NC) { const int step = step0 + (ch + 1) * TC + s; const int t = dir ? (L - 1 - step) : step;
                scan_load(nxt, ZR + (size_t)(seqbase + t) * 1536 + c, WA + (size_t)(seqbase + t) * 2048 + dir * 512 + c, t > 0, t < L - 1); }
            if (ch >= 2) { const int fc = ch - 2; LAS const float* yb = lf + (fc & 1) * BUF_FLOATS + 5 * ARR + TC * WR;
                const int step = step0 + fc * TC + s; const int t = dir ? (L - 1 - step) : step;
                SCAN_FLUSH(); }
            if (ch < NC) {
                LAS float* b = lf + (ch & 1) * BUF_FLOATS;
                float r[8], k[8], v[8], w[8], a[8];
                shift8r(cur.r[0], cur.r[1], cur.r[2], mu[0], mu[1], r);
                shift8r(cur.k[0], cur.k[1], cur.k[2], mu[2], mu[3], k);
                shift8r(cur.v[0], cur.v[1], cur.v[2], mu[4], mu[5], v);
                unpack8h(cur.w, w); unpack8h(cur.a, a);
                float kk[8], ss = 0.f;
#pragma unroll
                for (int e = 0; e < 8; ++e) { kk[e] = k[e] * kk_k[e]; ss += kk[e] * kk[e]; }
                ss = sum8(ss);
                const float inv = 1.0f / fmaxf(sqrtf(ss), 1e-12f);
                if (mode == 0 && part == 0) {
                    float bsum = 0.f;
#pragma unroll
                    for (int e = 0; e < 8; ++e) bsum += r[e] * (k[e] * (1.f + (a[e] - 1.f) * k_a[e])) * r_kk[e];
                    bsum = sum8(bsum);
                    const int stepb = step0 + ch * TC + s; const int tb = dir ? (L - 1 - stepb) : stepb;
                    if ((ptid & 7) == 0) BSd[(size_t)(seqbase + tb) * 8 + head] = bsum;
                }
                f32x4 o0, o1;
                LAS float* dst = b + s * 64 + d0;
#pragma unroll
                for (int e = 0; e < 4; ++e) { o0[e] = w[e]; o1[e] = w[4 + e]; }
                *(LAS f32x4*)(dst) = o0; *(LAS f32x4*)(dst + 4) = o1;
#pragma unroll
                for (int e = 0; e < 4; ++e) { o0[e] = k[e] * (1.f + (a[e] - 1.f) * k_a[e]); o1[e] = k[4 + e] * (1.f + (a[4 + e] - 1.f) * k_a[4 + e]); }
                *(LAS f32x4*)(dst + ARR) = o0; *(LAS f32x4*)(dst + ARR + 4) = o1;
#pragma unroll
                for (int e = 0; e < 4; ++e) { o0[e] = kk[e] * inv; o1[e] = kk[4 + e] * inv; }
                *(LAS f32x4*)(dst + 2 * ARR) = o0; *(LAS f32x4*)(dst + 2 * ARR + 4) = o1;
#pragma unroll
                for (int e = 0; e < 4; ++e) { o0[e] = kk[e] * inv * a[e]; o1[e] = kk[4 + e] * inv * a[4 + e]; }
                *(LAS f32x4*)(dst + 3 * ARR) = o0; *(LAS f32x4*)(dst + 3 * ARR + 4) = o1;
#pragma unroll
                for (int e = 0; e < 4; ++e) { o0[e] = r[e]; o1[e] = r[4 + e]; }
                *(LAS f32x4*)(dst + 4 * ARR) = o0; *(LAS f32x4*)(dst + 4 * ARR + 4) = o1;
                if (d0 >= rowbase && d0 < rowbase + WR) {
#pragma unroll
                    for (int e = 0; e < 8; ++e) b[5 * ARR + s * WR + (d0 - rowbase) + e] = mode ? 0.f : v[e]; }
            }
            cur = nxt;
            __syncthreads();
        }
        { const int fc = NC - 1; LAS const float* yb = lf + (fc & 1) * BUF_FLOATS + 5 * ARR + TC * WR;
          const int step = step0 + fc * TC + s; const int t = dir ? (L - 1 - step) : step;
          SCAN_FLUSH(); }
#undef SCAN_FLUSH
    } else if (is_scan) {
        const int i = lane >> 4, kq = lane & 15, lr0 = wave * (4 * RPL) + i * RPL;
        static_assert((2 * BUF_FLOATS + 4 * TC * WR) * 4 <= LDS_BYTES - 256, "scan LDS incl. the dummy Y region");
        const bool yleader = (kq & 3) == 0;
        f32x2 S[RPL][2];
#pragma unroll
        for (int q = 0; q < RPL; ++q) { const int gk = rowbase + lr0 + q - 4 * kq;
            S[q][0] = (f32x2){(mode && gk == 0) ? 1.f : 0.f, (mode && gk == 1) ? 1.f : 0.f}; S[q][1] = (f32x2){(mode && gk == 2) ? 1.f : 0.f, (mode && gk == 3) ? 1.f : 0.f}; }
        __syncthreads();
        for (int ch = 0; ch < NC; ++ch) {
            LAS const float* b = lf + (ch & 1) * BUF_FLOATS; LAS float* yb = lf + (ch & 1) * BUF_FLOATS + 5 * ARR + TC * WR;
            LAS float* ywb = (yleader ? yb : lf + 2 * BUF_FLOATS) + lr0 * 4 + (kq >> 2);
            f32x4 xw, xkd, xkk, xb, xr; float vrow[RPL];
#define SCAN_LD(ss) do { LAS const float* src_ = b + (ss) * 64 + kq * 4; xw = *(LAS const f32x4*)(src_); xkd = *(LAS const f32x4*)(src_ + ARR); xkk = *(LAS const f32x4*)(src_ + 2 * ARR); \
                xb = *(LAS const f32x4*)(src_ + 3 * ARR); xr = *(LAS const f32x4*)(src_ + 4 * ARR); _Pragma("unroll") for (int q = 0; q < RPL; ++q) vrow[q] = b[5 * ARR + (ss) * WR + lr0 + q]; } while (0)
            SCAN_LD(0);
#pragma unroll 8
            for (int s = 0; s < TC; ++s) {
                const f32x2 w0 = {xw[0], xw[1]}, w1 = {xw[2], xw[3]}, kd0 = {xkd[0], xkd[1]}, kd1 = {xkd[2], xkd[3]}, kk0 = {xkk[0], xkk[1]}, kk1 = {xkk[2], xkk[3]},
                            b0 = {xb[0], xb[1]}, b1 = {xb[2], xb[3]}, r0 = {xr[0], xr[1]}, r1 = {xr[2], xr[3]};
                float vr[RPL];
#pragma unroll
                for (int q = 0; q < RPL; ++q) vr[q] = vrow[q];
                { const int sn = (s + 1 < TC) ? s + 1 : s; SCAN_LD(sn); }
                float sa[RPL];
#pragma unroll
                for (int q = 0; q < RPL; ++q) { const f32x2 t = S[q][0] * kk0 + S[q][1] * kk1; sa[q] = t.x + t.y; }
                if (RPL == 2) {
                    sa[0] += dppx<0xB1>(sa[0]); sa[RPL - 1] += dppx<0xB1>(sa[RPL - 1]); sa[0] += dppx<0x4E>(sa[0]); sa[RPL - 1] += dppx<0x4E>(sa[RPL - 1]);
                    sa[0] += dppx<0x141>(sa[0]); sa[RPL - 1] += dppx<0x141>(sa[RPL - 1]); sa[0] += dppx<0x140>(sa[0]); sa[RPL - 1] += dppx<0x140>(sa[RPL - 1]);
                } else {
#pragma unroll
                    for (int q = 0; q < RPL; ++q) sa[q] = reduce16(sa[q]);
                }
                float ov[RPL];
                if (RPL == 2) {
                    const f32x2 vva = {vr[0], vr[0]}, nsa = {-sa[0], -sa[0]}, vvb = {vr[RPL - 1], vr[RPL - 1]}, nsb = {-sa[RPL - 1], -sa[RPL - 1]};
                    f32x2 a0 = nsa * b0, c0 = nsb * b0, a1 = nsa * b1, c1 = nsb * b1;
                    a0 = vva * kd0 + a0; c0 = vvb * kd0 + c0; a1 = vva * kd1 + a1; c1 = vvb * kd1 + c1;
                    S[0][0] = S[0][0] * w0 + a0; S[RPL - 1][0] = S[RPL - 1][0] * w0 + c0; S[0][1] = S[0][1] * w1 + a1; S[RPL - 1][1] = S[RPL - 1][1] * w1 + c1;
                    f32x2 ua = S[0][0] * r0, ub = S[RPL - 1][0] * r0;
                    ua = S[0][1] * r1 + ua; ub = S[RPL - 1][1] * r1 + ub;
                    ov[0] = ua.x + ua.y; ov[RPL - 1] = ub.x + ub.y;
                } else {
#pragma unroll
                for (int q = 0; q < RPL; ++q) {
                    const f32x2 vv = {vr[q], vr[q]}, ns = {-sa[q], -sa[q]};
                    S[q][0] = S[q][0] * w0 + (vv * kd0 + ns * b0);
                    S[q][1] = S[q][1] * w1 + (vv * kd1 + ns * b1);
                    const f32x2 t = S[q][0] * r0 + S[q][1] * r1; ov[q] = t.x + t.y;
                }
                }
#pragma unroll
                for (int q = 0; q < RPL; ++q) { ov[q] += dppx<0xB1>(ov[q]); ov[q] += dppx<0x4E>(ov[q]); }
                {
#pragma unroll
                    for (int q = 0; q < RPL; ++q) ywb[(s * WR + q) * 4] = ov[q]; }
            }
#undef SCAN_LD
            __syncthreads();
        }
        if (smid) {
#pragma unroll
            for (int q = 0; q < RPL; ++q) { const f32x4 sv = {S[q][0].x, S[q][0].y, S[q][1].x, S[q][1].y}; *(f32x4*)(smid + (size_t)(rowbase + lr0 + q) * 64 + 4 * kq) = sv; } }
    } else {
        for (int ch = 0; ch <= NC; ++ch) __syncthreads();
    }
}

__device__ __forceinline__ void scan_fix_item(const P& p, LAS unsigned char* lds, int hd, int blk) {
    int tid_ = threadIdx.x; asm volatile("" : "+v"(tid_));
    const int tid = tid_, wave = __builtin_amdgcn_readfirstlane(tid >> 6), lane = tid & 63;
    unsigned char* ws = p.ws;
    const float* smid = (const float*)(ws + WS_SMID) + (size_t)hd * 4096;
    const float* qc = (const float*)(ws + (hd < 12 ? WS_QC0 + (size_t)hd * 2 * MiB : WS_QC1 + (size_t)(hd - 12) * 2 * MiB)) + (size_t)blk * 128 * 64;
    bf16_t* Yd = (bf16_t*)(ws + WS_Y) + ((hd & 1) ? (size_t)T * 512 : 0);
    LAS float* lq = (LAS float*)lds;
    for (int i = tid; i < 128 * 16; i += 512) *(LAS f32x4*)(lq + i * 4) = *(const f32x4*)(qc + i * 4);
    f32x4 sm[16];
#pragma unroll
    for (int i = 0; i < 16; ++i) sm[i] = *(const f32x4*)(smid + lane * 64 + i * 4);
    __syncthreads();
    const int head = hd >> 1, dir = hd & 1;
    for (int s = 0; s < 16; ++s) {
        const int j = wave * 16 + s; LAS const float* q = lq + j * 64;
        float a0 = 0.f, a1 = 0.f, a2 = 0.f, a3 = 0.f;
#pragma unroll
        for (int i = 0; i < 16; ++i) { const f32x4 qv = *(LAS const f32x4*)(q + i * 4); a0 = fmaf(sm[i][0], qv[0], a0); a1 = fmaf(sm[i][1], qv[1], a1); a2 = fmaf(sm[i][2], qv[2], a2); a3 = fmaf(sm[i][3], qv[3], a3); }
        const int jj = blk * 128 + j; const int t = dir ? (8191 - jj) : (8192 + jj);
        bf16_t* yg = Yd + (size_t)(TP + t) * 512 + head * 64 + lane;
        const float yv = __uint_as_float((unsigned)*yg << 16) + ((a0 + a1) + (a2 + a3));
        *yg = (bf16_t)(pkbf(yv, yv) & 0xffffu);
    }
    __syncthreads();
}

#define XB_TMO      128
#define XB_XCNT(j)  (256  + 64 * (j))
#define XB_XSUB(j)  (1280 + 64 * (j))
#define XB_XGEN(j)  (2304 + 64 * (j))
#define XB_TOP      3328
#define XB_TOPGEN   3392
#define XCD_BAR_WORDS 3456
#define XB_SPIN_CAP (1u << 18)

__device__ __forceinline__ unsigned xb_ld(unsigned* p)              { return __hip_atomic_load(p, __ATOMIC_RELAXED, __HIP_MEMORY_SCOPE_AGENT); }
__device__ __forceinline__ unsigned xb_add(unsigned* p, unsigned v) { return __hip_atomic_fetch_add(p, v, __ATOMIC_RELAXED, __HIP_MEMORY_SCOPE_AGENT); }
__device__ __forceinline__ unsigned xb_xcc_id() { return (unsigned)__builtin_amdgcn_s_getreg((3 << 11) | 20) & 0xFu; }
#define XB_SPIN(cond, bar) do { unsigned _sp = 0; while (cond) { __builtin_amdgcn_s_sleep(1); \
    if ((++_sp & 255u) == 0u) { if (xb_ld(&(bar)[XB_TMO])) break; if (_sp > XB_SPIN_CAP) { atomicAdd(&(bar)[XB_TMO], 1u); break; } } } } while (0)

struct XcdBarrier {
    unsigned* bar; unsigned x;
    volatile LAS unsigned* st;
};

__device__ __forceinline__ XcdBarrier xcd_barrier_post(unsigned* bar, volatile LAS unsigned* st) {
    XcdBarrier b; b.bar = bar; b.x = xb_xcc_id(); b.st = st;
    if (threadIdx.x == 0) (void)xb_add(&bar[XB_XCNT(b.x)], 1u);
    return b;
}
__device__ __forceinline__ void xcd_barrier_complete(unsigned* bar, unsigned x, unsigned& nloc, unsigned& nx) {
    const unsigned G = gridDim.x * gridDim.y * gridDim.z;
    unsigned sum, cnt, mine, sp = 0u;
    for (;;) {
        sum = 0u; cnt = 0u; mine = 0u;
#pragma unroll
        for (unsigned j = 0; j < 16; ++j) { const unsigned c = xb_ld(&bar[XB_XCNT(j)]); sum += c; cnt += (c > 0u) ? 1u : 0u; mine = (j == x) ? c : mine; }
        if (sum == G) break;
        __builtin_amdgcn_s_sleep(1);
        if ((++sp & 255u) == 0u) { if (xb_ld(&bar[XB_TMO])) break; if (sp > XB_SPIN_CAP) { atomicAdd(&bar[XB_TMO], 1u); break; } }
    }
    nloc = mine > 0u ? mine : 1u; nx = cnt > 0u ? cnt : 1u;
}

__device__ __forceinline__ void xcd_barrier(const XcdBarrier& b) {
    asm volatile("s_waitcnt vmcnt(0)" ::: "memory");
    __syncthreads();
    if (threadIdx.x == 0) {
        unsigned* bar = b.bar;
        __builtin_amdgcn_s_waitcnt(0);
        unsigned nloc = b.st[0], nx = b.st[1];
        if (nloc == 0u) { xcd_barrier_complete(bar, b.x, nloc, nx); b.st[0] = nloc; b.st[1] = nx; }
        const unsigned old = xb_add(&bar[XB_XSUB(b.x)], 1u);
        const unsigned gen = old / nloc;
        if (old + 1u == (gen + 1u) * nloc) {
            __builtin_amdgcn_fence(__ATOMIC_RELEASE, "agent");
            asm volatile("s_waitcnt vmcnt(0)" ::: "memory");
            const unsigned og = xb_add(&bar[XB_TOP], 1u);
            const unsigned tg = og / nx;
            if (og + 1u == (tg + 1u) * nx) xb_add(&bar[XB_TOPGEN], 1u);
            else XB_SPIN(xb_ld(&bar[XB_TOPGEN]) == tg, bar);
            __builtin_amdgcn_fence(__ATOMIC_ACQUIRE, "agent");
            xb_add(&bar[XB_XGEN(b.x)], 1u);
            asm volatile("s_waitcnt vmcnt(0)" ::: "memory");
        } else {
            XB_SPIN(xb_ld(&bar[XB_XGEN(b.x)]) == gen, bar);
            __builtin_amdgcn_fence(__ATOMIC_ACQUIRE, "agent");
            asm volatile("s_waitcnt vmcnt(0)" ::: "memory");
        }
    }
    __syncthreads();
}
#ifndef NREP_ATT
#define NREP_ATT 1
#endif
#ifndef NREP_SCAN
#define NREP_SCAN 1
#endif
#ifndef NREP_G1
#define NREP_G1 1
#endif

#ifdef NO_GEMM
#define GEMM(EPI, EOBJ, AP, BP, NN, KK, LDA) do {} while(0)
#else
#define GEMM(EPI, EOBJ, AP, BP, NN, KK, LDA) do { pg8::Gemm g_{(const bf16_t*)(AP), (const bf16_t*)(BP), T, (NN), (KK), (LDA)}; pg8::StaticOrder S_; S_.init(T, (NN), G, bx); \
    pg8::gemm_phase<EPI, pg8::StaticOrder, true, true>(lds, g_, S_, EOBJ); } while (0)
#endif

__global__ void __launch_bounds__(512, 2) mega_fwd(const Args a) {
    extern __shared__ __attribute__((aligned(16))) unsigned char lds_raw[];
    cg::grid_group grid = cg::this_grid();
    LAS unsigned char* lds = (LAS unsigned char*)lds_raw;
    const Args& p = a;
    unsigned char* ws = a.ws; unsigned char* dout = (unsigned char*)a.out;
    const int tid = threadIdx.x, lane = tid & 63, wave = __builtin_amdgcn_readfirstlane(tid >> 6);
    const int G = gridDim.x, bx = blockIdx.x;
    const int vcu = (G % 8 == 0) ? (bx % 8) * (G / 8) + bx / 8 : bx;
    const int gw = vcu * 8 + wave, NGW = G * 8, gtid = bx * 512 + tid, GT = G * 512;
    bf16_t* XN = (bf16_t*)(ws + WS_U); bf16_t* ACT = (bf16_t*)(ws + WS_ACT); bf16_t* D1 = (bf16_t*)(ws + WS_D1);
    bf16_t* ZA = (bf16_t*)(ws + WS_ZA); bf16_t* ZRKV = (bf16_t*)(ws + WS_ZRKV); bf16_t* ZL = (bf16_t*)(ws + WS_ZL);
    bf16_t* MIX = (bf16_t*)(ws + WS_MIX); bf16_t* LIN = (bf16_t*)(ws + WS_LIN);
    bf16_t* Qb = (bf16_t*)(dout + DO_Q); bf16_t* Kb = (bf16_t*)(dout + DO_K); bf16_t* Vb = (bf16_t*)(dout + DO_V);
    unsigned short* WA = (unsigned short*)(dout + DO_WA); float* H = a.out;
    const float* rope = (const float*)(ws + WS_ROPE);

    volatile LAS unsigned* bst = (volatile LAS unsigned*)(lds + LDS_BYTES - 128);
    if (tid < 2) bst[tid] = 0u;
    __syncthreads();
    const XcdBarrier xbar = xcd_barrier_post((unsigned*)(ws + WS_BAR), bst);
#define GSYNC() xcd_barrier(xbar)
    prologue(p, lds, gw, NGW, wave, lane, gtid, GT, G == 256 ? 1 : 0);
    for (int m = gw; m < T; m += NGW) norm_row(xrow(p, m), nullptr, p.in[2], XN + (size_t)m * DM, nullptr, lane);
    if (a.out == nullptr) grid.sync();
    GSYNC();
#ifndef NO_EpiSwiGLU
    for (int rep_ = 0; rep_ < NREP_G1; ++rep_) { EpiSwiGLU E{ACT}; GEMM(EpiSwiGLU, E, XN, ws + WS_WGU1, 2 * DFF, DM, DM); }
#endif
    GSYNC();
#ifndef NO_EpiScaleBf16
    { EpiScaleBf16 E{D1, 0.5f}; GEMM(EpiScaleBf16, E, ACT, ws + WS_WD1, DM, DFF, DFF); }
#endif
    GSYNC();
    for (int m = gw; m < T; m += NGW) norm_row(xrow(p, m), D1 + (size_t)m * DM, p.in[6], XN + (size_t)m * DM, nullptr, lane);
    GSYNC();
#ifndef NO_EpiZ
    { EpiZ E{ZA, ZRKV, ZL}; GEMM(EpiZ, E, XN, ws + WS_WIN, 2816, DM, DM); }
#endif
    GSYNC();
    for (int m = gw; m < T; m += NGW) p5_row(p, m, lane);
    GSYNC();
#ifndef NO_EpiPlain
    { EpiPlain E{Qb, 768}; GEMM(EpiPlain, E, ZA, ws + WS_WUQ, 768, 384, 768); }
#endif
#ifndef NO_EpiKV
    { EpiKV E{Kb, Vb}; GEMM(EpiKV, E, ZA + 384, ws + WS_WUKV, 1024, 256, 768); }
#endif
    GSYNC();
#ifndef NO_ATT
    for (int rep_ = 0; rep_ < NREP_ATT; ++rep_) {
        char* ldsg = (char*)lds_raw;
        if (G == 256) {
            const int xcd = vcu >> 5, j = vcu & 31;
            for (int i = 0; i < 2; ++i) { const int head = xcd, qb = j + 32 * i; const size_t r0 = (size_t)TP + (size_t)qb * 256;
                att::attn_unit(Qb + r0 * 768 + head * 96, Kb + (size_t)TP * 768 + head * 96, Vb + (size_t)TP * 512 + head * 64, MIX + r0 * 1024 + head * 64, 16384, ldsg, rope, qb * 256); }
            for (int i = 0; i < 4; ++i) { const int pi = 4 * xcd + i, seq = pi >> 3, head = pi & 7; const size_t sb = (size_t)seq * 8192, r0 = sb + (size_t)j * 256;
                att::attn_unit(Qb + r0 * 768 + head * 96, Kb + sb * 768 + head * 96, Vb + sb * 512 + head * 64, MIX + r0 * 1024 + head * 64, 8192, ldsg, rope, j * 256); }
        } else {
            for (int u = vcu; u < 1536; u += G) {
                size_t sb, r0; int head, L;
                if (u < 512) { head = u >> 6; sb = TP; r0 = sb + (size_t)(u & 63) * 256; L = 16384; }
                else { const int v = u - 512; const int seq = v >> 8; head = (v >> 5) & 7; sb = (size_t)seq * 8192; r0 = sb + (size_t)(v & 31) * 256; L = 8192; }
                att::attn_unit(Qb + r0 * 768 + head * 96, Kb + sb * 768 + head * 96, Vb + sb * 512 + head * 64, MIX + r0 * 1024 + head * 64, L, ldsg, rope, (int)(r0 - sb));
            }
        }
    }
#endif
    GSYNC();
#ifndef NO_EpiLora
    { EpiLora E{WA, MIX, p.in[14], p.in[16], 0}; GEMM(EpiLora, E, LIN, ws + WS_WL, 1024, 128, 384); }
    { EpiLora E{WA, MIX, p.in[14], p.in[16], 2}; GEMM(EpiLora, E, LIN + 128, ws + WS_WL + 262144, 1024, 128, 384); }
    { EpiLora E{WA, MIX, p.in[14], p.in[16], 4}; GEMM(EpiLora, E, LIN + 256, ws + WS_WL + 524288, 512, 128, 384); }
#endif
    GSYNC();
#ifndef NO_SCAN
    {
        if (G == 256 && vcu >= 224) { prologue(p, lds, (vcu - 224) * 8 + wave, 32 * 8, wave, lane, 0, 1, 2);
            for (int m = (vcu - 224) * 8 + wave; m < T; m += 32 * 8) p10_att_row(p, m, lane); }
        for (int item = vcu; item < 224; item += G) {
            int sb_, L_, head_, dir_, part_ = item & 1, step0_ = 0, mode_ = 0; float* qcp_ = nullptr; float* smp_ = nullptr;
            if (item < 96) { const int kind = (item >> 1) % 3, hd = item / 6; head_ = hd >> 1; dir_ = hd & 1; sb_ = TP; L_ = 16384;
                qcp_ = (float*)(ws + (hd < 12 ? WS_QC0 + (size_t)hd * 2 * MiB : WS_QC1 + (size_t)(hd - 12) * 2 * MiB));
                if (kind == 0) smp_ = (float*)(ws + WS_SMID) + (size_t)hd * 4096; else step0_ = 8192;
                mode_ = kind == 2 ? 1 : 0; }
            else { const int j = (item - 96) >> 1; sb_ = (j >> 4) * 8192; L_ = 8192; head_ = (j >> 1) & 7; dir_ = j & 1; }
            scan_item<2, 4>(p, lds, sb_, L_, head_, dir_, part_, step0_, 8192, mode_, qcp_, smp_);
            __syncthreads();
        }
    }
    GSYNC();
    for (int it = vcu; it < 16 * 64; it += G) scan_fix_item(p, lds, it >> 6, it & 63);
#endif
    GSYNC();
    for (int m = gw; m < T; m += NGW) { if (G != 256) p10_att_row(p, m, lane); p10_row(p, m, lane); }
    GSYNC();
#ifndef NO_EpiOut
    { EpiOut E{p.in[0], p.in[1], D1}; GEMM(EpiOut, E, MIX, ws + WS_WOUT, DM, DM, DM); }
#endif
    GSYNC();
    for (int m = gw; m < T; m += NGW) norm_row_bf(D1 + (size_t)m * DM, p.in[25], XN + (size_t)m * DM, nullptr, lane);
    GSYNC();
#ifndef NO_EpiSwiGLU
    { EpiSwiGLU E{ACT}; GEMM(EpiSwiGLU, E, XN, ws + WS_WGU2, 2 * DFF, DM, DM); }
#endif
    GSYNC();
#ifndef NO_EpiDown2
    { EpiDown2 E{D1}; GEMM(EpiDown2, E, ACT, ws + WS_WD2, DM, DFF, DFF); }
#endif
    GSYNC();
    for (int m = gw; m < T; m += NGW) norm_row_bf(D1 + (size_t)m * DM, p.in[29], nullptr, H + (size_t)m * DM, lane);
}

extern "C" void kernel_launch(void* const* d_in, const int* in_sizes, int n_in, void* d_out, int out_size, void* d_ws, size_t ws_size, hipStream_t stream) {
    static int grid = 0;
    if (grid == 0) {
        if (n_in != 30 || in_sizes[0] != TP * DM || in_sizes[1] != TS * DM || out_size != T * DM || ws_size < WS_END) {
            fprintf(stderr, "kernel_launch: unexpected shapes: n_in %d in0 %d in1 %d out %d ws %zu (need >= %zu)\n", n_in, n_in > 0 ? in_sizes[0] : -1, n_in > 1 ? in_sizes[1] : -1, out_size, ws_size, (size_t)WS_END);
            grid = -1; return; }
        int dev = 0, cus = 0, per_cu = 0;
        if (hipGetDevice(&dev) != hipSuccess || hipDeviceGetAttribute(&cus, hipDeviceAttributeMultiprocessorCount, dev) != hipSuccess) { fprintf(stderr, "kernel_launch: device query failed\n"); grid = -1; return; }
        if (hipFuncSetAttribute((const void*)mega_fwd, hipFuncAttributeMaxDynamicSharedMemorySize, LDS_BYTES) != hipSuccess) { fprintf(stderr, "kernel_launch: hipFuncSetAttribute failed\n"); grid = -1; return; }
        if (hipOccupancyMaxActiveBlocksPerMultiprocessor(&per_cu, (const void*)mega_fwd, 512, LDS_BYTES) != hipSuccess || per_cu < 1) { fprintf(stderr, "kernel_launch: occupancy query says %d\n", per_cu); per_cu = 1; }
        (void)hipGetLastError();
        grid = cus * 1;
    }
    if (grid < 0) return;
    (void)hipMemsetAsync((char*)d_ws + WS_CTL, 0, WS_ZERO_BYTES, stream);
    Args a{};
    for (int i = 0; i < 30; ++i) a.in[i] = (const float*)d_in[i];
    a.out = (float*)d_out; a.ws = (unsigned char*)d_ws;
    void* args[] = {&a};
    hipError_t e = hipLaunchCooperativeKernel((const void*)mega_fwd, dim3(grid), dim3(512), args, LDS_BYTES, stream);
    if (e != hipSuccess) fprintf(stderr, "kernel_launch: cooperative launch failed: %s (grid %d)\n", hipGetErrorString(e), grid);
}
```
